# Optimizing an MI355X kernel written in HIP

```python
import jax, jax.numpy as jnp
from jax import lax
import numpy as np

D_MODEL = 2048
BATCH = 2
SEQ = 4096
DEPTH = 2

GRID_W = 64
CTX_LEN = 256
N_MIXERS = 2
N_ADA = 6
EPS = 1e-6
CONV_K = 31
CONV_PAD = CONV_K // 2
LRU_HEADS = 16
LRU_BLOCK = D_MODEL // LRU_HEADS
LRU_C = 8.0
LRU_CONV_K = 4
LRU_CONV_PAD = (1, 2)
N_EXPERTS = 32
TOP_K = 4
D_FF = D_MODEL // 2
SWIGLU_ALPHA = 1.702
SWIGLU_LIMIT = 7.0
N_CONV_LAYERS = (DEPTH + 1) // 2
N_LRU_LAYERS = DEPTH // 2

kernel_name = "hybrid_conformer_rglru_moe_dit"


def rmsnorm(x, g):
    xf = x.astype(jnp.float32)
    y = xf * lax.rsqrt(jnp.mean(xf * xf, axis=-1, keepdims=True) + EPS)
    return (y * g.astype(jnp.float32)).astype(x.dtype)


def layernorm(x, g, b):
    xf = x.astype(jnp.float32)
    mu = jnp.mean(xf, axis=-1, keepdims=True)
    xc = xf - mu
    y = xc * lax.rsqrt(jnp.mean(xc * xc, axis=-1, keepdims=True) + EPS)
    return (y * g.astype(jnp.float32) + b.astype(jnp.float32)).astype(x.dtype)


def modulate(xn, shift, scale):
    return xn * (1.0 + scale) + shift


def depthwise_conv1d(x, w, pad):
    ch = x.shape[-1]
    return lax.conv_general_dilated(
        x, w[:, None, :].astype(x.dtype), window_strides=(1,), padding=[pad],
        dimension_numbers=("NWC", "WIO", "NWC"), feature_group_count=ch)


def grid_axial_depthwise_conv(x, w):
    bsz, n, d = x.shape
    rows = n // GRID_W
    half = d // 2
    g = x.reshape(bsz, rows, GRID_W, d)
    gh = g[..., :half].reshape(bsz * rows, GRID_W, half)
    yh = depthwise_conv1d(gh, w[:, :half], (CONV_PAD, CONV_PAD)).reshape(bsz, rows, GRID_W, half)
    gv = jnp.swapaxes(g[..., half:], 1, 2).reshape(bsz * GRID_W, rows, half)
    yv = depthwise_conv1d(gv, w[:, half:], (CONV_PAD, CONV_PAD)).reshape(bsz, GRID_W, rows, half)
    yv = jnp.swapaxes(yv, 1, 2)
    return jnp.concatenate([yh, yv], axis=-1).reshape(bsz, n, d)


def conformer_conv_module(xm, on_grid, pw1_w, pw1_b, dw_w, dw_b, ln_g, ln_b, pw2_w, pw2_b):
    u = xm @ pw1_w + pw1_b
    v = u[..., :D_MODEL] * jax.nn.sigmoid(u[..., D_MODEL:])
    if on_grid:
        v = grid_axial_depthwise_conv(v, dw_w)
    else:
        v = depthwise_conv1d(v, dw_w, (CONV_PAD, CONV_PAD))
    v = layernorm(v + dw_b, ln_g, ln_b)
    v = jax.nn.silu(v)
    return v @ pw2_w + pw2_b


def lru_gates(xb, wa, ba, wi, bi, lam):
    bsz, n, d = xb.shape
    xh = xb.reshape(bsz, n, LRU_HEADS, LRU_BLOCK)
    r = jax.nn.sigmoid(jnp.einsum("bnhi,hij->bnhj", xh, wa).reshape(bsz, n, d) + ba)
    i = jax.nn.sigmoid(jnp.einsum("bnhi,hij->bnhj", xh, wi).reshape(bsz, n, d) + bi)
    log_a = -LRU_C * r.astype(jnp.float32) * jax.nn.softplus(-lam.astype(jnp.float32))
    a = jnp.exp(log_a)
    mult = jnp.sqrt(-jnp.expm1(2.0 * log_a))
    u = xb.astype(jnp.float32) * i.astype(jnp.float32) * mult
    return a, u


def linear_scan(a, u, h0):
    u = u.at[:, 0].add(a[:, 0] * h0)
    def combine(earlier, later):
        return (earlier[0] * later[0], later[0] * earlier[1] + later[1])
    _, h = lax.associative_scan(combine, (a, u), axis=1)
    return h


def rglru_block(xc, xl, ctx_out, wy, by, wx, bx, conv_w, conv_b, wa, ba, wi, bi, lam, wo, bo):
    dt = xl.dtype
    def conv_branch(xm):
        return depthwise_conv1d(xm @ wx + bx, conv_w, LRU_CONV_PAD) + conv_b
    xbc = conv_branch(xc)
    xbl = conv_branch(xl)
    bsz = xl.shape[0]
    h0 = jnp.zeros((bsz, D_MODEL), jnp.float32)
    rnn_c = 0.0
    rnn_l = 0.0
    for d in range(2):
        ac, uc = lru_gates(xbc, wa[d], ba[d], wi[d], bi[d], lam[d])
        al, ul = lru_gates(xbl, wa[d], ba[d], wi[d], bi[d], lam[d])
        if d == 1:
            ac, uc, al, ul = (jnp.flip(t, axis=1) for t in (ac, uc, al, ul))
        hc = linear_scan(ac, uc, h0)
        hl = linear_scan(al, ul, hc[:, -1])
        if d == 1:
            hc = jnp.flip(hc, axis=1)
            hl = jnp.flip(hl, axis=1)
        rnn_c = rnn_c + hc
        rnn_l = rnn_l + hl
    yl = jax.nn.gelu(xl @ wy + by)
    out_l = (yl * rnn_l.astype(dt)) @ wo + bo
    out_c = None
    if ctx_out:
        yc = jax.nn.gelu(xc @ wy + by)
        out_c = (yc * rnn_c.astype(dt)) @ wo + bo
    return out_l, out_c


def moe_ffn(h, router_w, router_b, w1, b1, w2, b2):
    t = h.reshape(-1, D_MODEL)
    logits = (t @ router_w + router_b).astype(jnp.float32)
    top_v, top_i = lax.top_k(logits, TOP_K)
    probs = jax.nn.softmax(top_v, axis=-1)
    gate = jnp.sum(jax.nn.one_hot(top_i, N_EXPERTS, dtype=jnp.float32) * probs[..., None], axis=1)

    def expert_step(acc, xs):
        w1e, b1e, w2e, b2e, ge = xs
        hh = t @ w1e + b1e
        glu = jnp.minimum(hh[:, :D_FF], SWIGLU_LIMIT)
        lin = jnp.clip(hh[:, D_FF:], -SWIGLU_LIMIT, SWIGLU_LIMIT)
        act = glu * jax.nn.sigmoid(SWIGLU_ALPHA * glu) * (lin + 1.0)
        y = act @ w2e + b2e
        return acc + ge[:, None].astype(acc.dtype) * y, None

    out, _ = lax.scan(expert_step, jnp.zeros_like(t), (w1, b1, w2, b2, gate.T))
    return out.reshape(h.shape)


def setup_inputs(seed: int = 0) -> dict:
    key = jax.random.key(seed)
    ks = iter(jax.random.split(key, 40))
    f32 = jnp.float32
    D, E, F = D_MODEL, N_EXPERTS, D_FF
    NA, NB = N_CONV_LAYERS, N_LRU_LAYERS
    nrm = lambda shape, s: jax.random.normal(next(ks), shape, f32) * s
    gain = lambda shape: 1.0 + nrm(shape, 0.01)
    u = jax.random.uniform(next(ks), (NB, 2, D), f32, 0.9, 0.999)
    sig = u ** (1.0 / LRU_C)
    lam = jnp.log(sig) - jnp.log1p(-sig)
    return {
        "x": nrm((BATCH, SEQ, D), 1.0),
        "c": nrm((BATCH, D), 1.0),
        "ctx": nrm((BATCH, CTX_LEN, D), 1.0),
        "c_ctx": nrm((D,), 1.0),
        "ada_w": nrm((DEPTH, D, N_ADA * D), 0.5 * D ** -0.5),
        "ada_b": nrm((DEPTH, N_ADA * D), 0.02),
        "norm1_g": gain((DEPTH, D)),
        "norm2_g": gain((DEPTH, D)),
        "conv_pw1_w": nrm((NA, D, 2 * D), D ** -0.5),
        "conv_pw1_b": nrm((NA, 2 * D), 0.01),
        "conv_dw_w": nrm((NA, CONV_K, D), CONV_K ** -0.5),
        "conv_dw_b": nrm((NA, D), 0.01),
        "conv_ln_g": gain((NA, D)),
        "conv_ln_b": nrm((NA, D), 0.01),
        "conv_pw2_w": nrm((NA, D, D), D ** -0.5),
        "conv_pw2_b": nrm((NA, D), 0.01),
        "lru_wy": nrm((NB, D, D), D ** -0.5),
        "lru_by": nrm((NB, D), 0.01),
        "lru_wx": nrm((NB, D, D), D ** -0.5),
        "lru_bx": nrm((NB, D), 0.01),
        "lru_conv_w": nrm((NB, LRU_CONV_K, D), LRU_CONV_K ** -0.5),
        "lru_conv_b": nrm((NB, D), 0.01),
        "lru_wa": nrm((NB, 2, LRU_HEADS, LRU_BLOCK, LRU_BLOCK), LRU_BLOCK ** -0.5),
        "lru_ba": nrm((NB, 2, D), 0.01),
        "lru_wi": nrm((NB, 2, LRU_HEADS, LRU_BLOCK, LRU_BLOCK), LRU_BLOCK ** -0.5),
        "lru_bi": nrm((NB, 2, D), 0.01),
        "lru_lambda": lam,
        "lru_wo": nrm((NB, D, D), D ** -0.5),
        "lru_bo": nrm((NB, D), 0.01),
        "router_w": nrm((DEPTH, D, E), D ** -0.5),
        "router_b": nrm((DEPTH, E), 0.01),
        "moe_w1": nrm((DEPTH, E, D, 2 * F), D ** -0.5),
        "moe_b1": nrm((DEPTH, E, 2 * F), 0.01),
        "moe_w2": nrm((DEPTH, E, F, D), F ** -0.5),
        "moe_b2": nrm((DEPTH, E, D), 0.01),
        "final_g": gain((D,)),
    }


def reference(x, c, ctx, c_ctx, ada_w, ada_b, norm1_g, norm2_g,
              conv_pw1_w, conv_pw1_b, conv_dw_w, conv_dw_b, conv_ln_g, conv_ln_b, conv_pw2_w, conv_pw2_b,
              lru_wy, lru_by, lru_wx, lru_bx, lru_conv_w, lru_conv_b, lru_wa, lru_ba, lru_wi, lru_bi,
              lru_lambda, lru_wo, lru_bo,
              router_w, router_b, moe_w1, moe_b1, moe_w2, moe_b2, final_g):
    h_lat = x
    h_ctx = ctx
    src_lat = jax.nn.silu(c)
    src_ctx = jax.nn.silu(c_ctx)[None]
    ia = 0
    ib = 0
    for layer in range(DEPTH):
        last = layer == DEPTH - 1
        m_lat = (src_lat @ ada_w[layer] + ada_b[layer])[:, None, :]
        m_ctx = (src_ctx @ ada_w[layer] + ada_b[layer])[:, None, :]
        sh1_l, sc1_l, g1_l, sh2_l, sc2_l, g2_l = jnp.split(m_lat, N_ADA, axis=-1)
        sh1_c, sc1_c, g1_c, sh2_c, sc2_c, g2_c = jnp.split(m_ctx, N_ADA, axis=-1)

        xn_l = modulate(rmsnorm(h_lat, norm1_g[layer]), sh1_l, sc1_l)
        xn_c = modulate(rmsnorm(h_ctx, norm1_g[layer]), sh1_c, sc1_c)
        if layer % N_MIXERS == 0:
            pa = (conv_pw1_w[ia], conv_pw1_b[ia], conv_dw_w[ia], conv_dw_b[ia],
                  conv_ln_g[ia], conv_ln_b[ia], conv_pw2_w[ia], conv_pw2_b[ia])
            out_l = conformer_conv_module(xn_l, True, *pa)
            out_c = None if last else conformer_conv_module(xn_c, False, *pa)
            ia += 1
        else:
            out_l, out_c = rglru_block(
                xn_c, xn_l, not last,
                lru_wy[ib], lru_by[ib], lru_wx[ib], lru_bx[ib], lru_conv_w[ib], lru_conv_b[ib],
                lru_wa[ib], lru_ba[ib], lru_wi[ib], lru_bi[ib], lru_lambda[ib], lru_wo[ib], lru_bo[ib])
            ib += 1
        h_lat = h_lat + g1_l * out_l

        fn_l = modulate(rmsnorm(h_lat, norm2_g[layer]), sh2_l, sc2_l)
        moe_p = (router_w[layer], router_b[layer], moe_w1[layer], moe_b1[layer],
                 moe_w2[layer], moe_b2[layer])
        if last:
            h_lat = h_lat + g2_l * moe_ffn(fn_l, *moe_p)
        else:
            h_ctx = h_ctx + g1_c * out_c
            fn_c = modulate(rmsnorm(h_ctx, norm2_g[layer]), sh2_c, sc2_c)
            ff = moe_ffn(jnp.concatenate([fn_c, fn_l], axis=1), *moe_p)
            h_ctx = h_ctx + g2_c * ff[:, :CTX_LEN]
            h_lat = h_lat + g2_l * ff[:, CTX_LEN:]
    return rmsnorm(h_lat, final_g)
```

```cpp
#include <hip/hip_runtime.h>
#include <cstdio>
#include <cstdint>

#ifndef MK_PER_PHASE
#define MK_PER_PHASE 0
#endif
#ifndef DENSE_FP8
#define DENSE_FP8 0
#endif
#ifndef PROBE_PHASE
#define PROBE_PHASE -1
#endif
#ifndef PROBE_COLD
#define PROBE_COLD 0
#endif
#ifndef PROBE_REP
#define PROBE_REP 2
#endif

#define GAS __attribute__((address_space(1)))
#define LAS __attribute__((address_space(3)))
typedef unsigned short bf16;
typedef short bf16x8 __attribute__((ext_vector_type(8)));
typedef float f32x4 __attribute__((ext_vector_type(4)));
typedef float f32x2 __attribute__((ext_vector_type(2)));
typedef unsigned u32x4 __attribute__((ext_vector_type(4)));
typedef unsigned u32x2 __attribute__((ext_vector_type(2)));

constexpr int D = 2048, NBATCH = 2, SEQ = 4096, CTXL = 256, GRIDW = 64;
constexpr int TL = NBATCH * SEQ;
constexpr int TC = NBATCH * CTXL;
constexpr int TT = TL + TC;
constexpr int NE = 32, TOPK = 4, FF = 1024;
constexpr int CONVK = 31, CONVP = 15;
constexpr int NHEAD = 16, HBLK = 128;
constexpr float EPS = 1e-6f;
constexpr int NTHREADS = 512, NWAVES = 8;
constexpr int TM = 256;
constexpr int LCAP = TT;
constexpr int ACT_ROWS = TT * TOPK + NE * TM;

enum { I_X = 0, I_C, I_CTX, I_CCTX, I_ADAW, I_ADAB, I_N1G, I_N2G, I_PW1W, I_PW1B, I_DWW, I_DWB, I_LNG, I_LNB, I_PW2W, I_PW2B,
       I_WY, I_BY, I_WX, I_BX, I_LCW, I_LCB, I_WA, I_BA, I_WI, I_BI, I_LAM, I_WO, I_BO, I_RW, I_RB, I_W1, I_B1, I_W2, I_B2, I_FG, N_IN };

constexpr size_t MiB = 1u << 20;
constexpr size_t ALN(size_t x) { return (x + MiB - 1) / MiB * MiB; }
constexpr size_t U16ROWS = (size_t)TT * D * 2;
constexpr size_t F32ROWS = (size_t)TT * D * 4;
constexpr size_t WS_CTL = 0, CTL_BYTES = 1 * MiB, CTL_ZERO = 32768;
constexpr size_t WS_MOD = WS_CTL + CTL_BYTES;
constexpr size_t WS_LIST = WS_MOD + ALN((size_t)2 * 3 * 6 * D * 4);
constexpr size_t WS_PSLOT = WS_LIST + ALN((size_t)3 * NE * LCAP * 4);
constexpr size_t WS_PLIST = WS_PSLOT + ALN((size_t)3 * TT * 4 * 4);
constexpr size_t WS_RWF = WS_PLIST + ALN((size_t)3 * NE * LCAP * 4);
constexpr size_t WS_RC = WS_RWF + ALN((size_t)6 * D * NE * 4);
constexpr size_t WS_DELTA = WS_RC + MiB;
constexpr size_t WS_XN0 = WS_DELTA + ALN(U16ROWS);
constexpr size_t WS_V = WS_XN0 + ALN(U16ROWS);
constexpr size_t WS_CV = WS_V + ALN(U16ROWS);
constexpr size_t WS_A2 = WS_CV + ALN(U16ROWS);
constexpr size_t WS_H1 = WS_A2 + ALN(U16ROWS);
constexpr size_t WS_FN0 = WS_H1 + ALN(F32ROWS);
constexpr size_t WS_ACT0 = WS_FN0 + ALN(U16ROWS);
constexpr size_t WS_Y0 = WS_ACT0 + ALN((size_t)ACT_ROWS * FF * 2);
constexpr size_t WS_H2 = WS_Y0 + ALN((size_t)(TT * 4 + 1024) * D * 2);
constexpr size_t WS_XN1 = WS_H2 + ALN(F32ROWS);
constexpr size_t WS_XB = WS_XN1 + ALN(U16ROWS);
constexpr size_t WS_YL = WS_XB + ALN(U16ROWS);
constexpr size_t WS_XBC = WS_YL + ALN(U16ROWS);
constexpr size_t WS_AARR = WS_XBC + ALN(U16ROWS);
constexpr size_t WS_UARR = WS_AARR + ALN(2 * F32ROWS);
constexpr size_t WS_HL = WS_UARR + ALN(2 * F32ROWS);
constexpr size_t WS_PP = WS_HL + ALN((size_t)2 * TL * D * 2);
constexpr size_t WS_SA = WS_PP + ALN((size_t)2 * TL * D * 2);
constexpr size_t WS_SU = WS_SA + ALN((size_t)136 * 2 * D * 4);
constexpr size_t WS_Z = WS_SU + ALN((size_t)136 * 2 * D * 4);
constexpr size_t WS_H3 = WS_Z + ALN(U16ROWS);
constexpr size_t WS_FN1 = WS_H3 + ALN(F32ROWS);
constexpr size_t WS_ACT1 = WS_FN1 + ALN(U16ROWS);
constexpr size_t WS_Y1 = WS_ACT1 + ALN((size_t)ACT_ROWS * FF * 2);
constexpr size_t WS_WPW1 = WS_Y1 + ALN((size_t)(TT * 4 + 1024) * D * 2);
constexpr size_t WS_WPW2 = WS_WPW1 + ALN((size_t)2 * D * D * 2);
constexpr size_t WS_WXY = WS_WPW2 + ALN((size_t)D * D * 2);
constexpr size_t WS_WWO = WS_WXY + ALN((size_t)2 * D * D * 2);
constexpr size_t WS_WM1 = WS_WWO + ALN((size_t)D * D * 2);
constexpr size_t WS_WM2 = WS_WM1 + ALN((size_t)2 * NE * 2 * FF * D * 2);
constexpr size_t WS_END = WS_WM2 + ALN((size_t)2 * NE * D * FF * 2);

constexpr int CW_TMO = 0;
constexpr int CW_CNT = 1024;
constexpr int CW_BAR = 4096;

constexpr int LDS_BYTES = 163840;
constexpr int LDS_MISC = 151552;
constexpr int LDS_EP = LDS_MISC + 4096;

constexpr float W8_SCALE = 64.0f, W8_INV = 1.0f / 64.0f;
constexpr bool F8_PW1 = (DENSE_FP8 & 1) != 0, F8_PW2 = (DENSE_FP8 & 2) != 0, F8_WXY = (DENSE_FP8 & 4) != 0, F8_WO = (DENSE_FP8 & 8) != 0;
__host__ __device__ constexpr bool dense_tile_f8(int tile) { return tile < 16 ? F8_PW1 : (tile < 24 ? F8_PW2 : (tile < 40 ? F8_WXY : F8_WO)); }
__device__ __forceinline__ unsigned f2bf(float f) { unsigned u = __builtin_bit_cast(unsigned, f); return (u + 0x7fffu + ((u >> 16) & 1u)) >> 16; }
typedef __bf16 bf16x2_hw __attribute__((ext_vector_type(2)));
__device__ __forceinline__ unsigned pk2(float lo, float hi) { const f32x2 f = {lo, hi}; return __builtin_bit_cast(unsigned, __builtin_convertvector(f, bf16x2_hw)); }
__device__ __forceinline__ unsigned pk4_fp8(float a, float b, float c, float d) { int w = 0; w = __builtin_amdgcn_cvt_pk_fp8_f32(a, b, w, false); w = __builtin_amdgcn_cvt_pk_fp8_f32(c, d, w, true); return (unsigned)w; }
__device__ __forceinline__ float bf_lo(unsigned w) { return __builtin_bit_cast(float, w << 16); }
__device__ __forceinline__ float bf_hi(unsigned w) { return __builtin_bit_cast(float, w & 0xffff0000u); }
__device__ __forceinline__ float sigmoidf_(float x) { return __builtin_amdgcn_rcpf(1.0f + __builtin_amdgcn_exp2f(-1.4426950408889634f * x)); }
__device__ __forceinline__ float siluf_(float x) { return x * sigmoidf_(x); }
__device__ __forceinline__ float gelu_tanh(float x) { const float y = 0.7978845608028654f * (x + 0.044715f * x * x * x); const float t = 1.0f - 2.0f * __builtin_amdgcn_rcpf(__builtin_amdgcn_exp2f(2.885390081777927f * y) + 1.0f); return 0.5f * x * (1.0f + t); }
__device__ __forceinline__ float wave_sum(float v) {
#pragma unroll
    for (int o = 1; o < 64; o <<= 1) v += __shfl_xor(v, o);
    return v;
}

#define XB_TMO      128
#define XB_XCNT(j)  (256  + 64 * (j))
#define XB_XSUB(j)  (1280 + 64 * (j))
#define XB_XGEN(j)  (2304 + 64 * (j))
#define XB_TOP      3328
#define XB_TOPGEN   3392
#define XCD_BAR_WORDS 3456
#define XB_SPIN_CAP (1u << 18)

__device__ __forceinline__ unsigned xb_ld(unsigned* p)              { return __hip_atomic_load(p, __ATOMIC_RELAXED, __HIP_MEMORY_SCOPE_AGENT); }
__device__ __forceinline__ unsigned xb_add(unsigned* p, unsigned v) { return __hip_atomic_fetch_add(p, v, __ATOMIC_RELAXED, __HIP_MEMORY_SCOPE_AGENT); }
__device__ __forceinline__ unsigned xb_xcc_id() { return (unsigned)__builtin_amdgcn_s_getreg((3 << 11) | 20) & 0xFu; }
#define XB_SPIN(cond, bar) do { unsigned _sp = 0; while (cond) { __builtin_amdgcn_s_sleep(1); \
    if ((++_sp & 255u) == 0u) { if (xb_ld(&(bar)[XB_TMO])) break; if (_sp > XB_SPIN_CAP) { atomicAdd(&(bar)[XB_TMO], 1u); break; } } } } while (0)

struct XcdBarrier {
    unsigned* bar; unsigned x;
    volatile LAS unsigned* st;
};

__device__ __forceinline__ XcdBarrier xcd_barrier_post(unsigned* bar, volatile LAS unsigned* st) {
    XcdBarrier b; b.bar = bar; b.x = xb_xcc_id(); b.st = st;
    if (threadIdx.x == 0) (void)xb_add(&bar[XB_XCNT(b.x)], 1u);
    return b;
}
__device__ __forceinline__ void xcd_barrier_complete(unsigned* bar, unsigned x, unsigned& nloc, unsigned& nx) {
    const unsigned G = gridDim.x * gridDim.y * gridDim.z;
    unsigned sum, cnt, mine, sp = 0u;
    for (;;) {
        sum = 0u; cnt = 0u; mine = 0u;
#pragma unroll
        for (unsigned j = 0; j < 16; ++j) { const unsigned c = xb_ld(&bar[XB_XCNT(j)]); sum += c; cnt += (c > 0u) ? 1u : 0u; mine = (j == x) ? c : mine; }
        if (sum == G) break;
        __builtin_amdgcn_s_sleep(1);
        if ((++sp & 255u) == 0u) { if (xb_ld(&bar[XB_TMO])) break; if (sp > XB_SPIN_CAP) { atomicAdd(&bar[XB_TMO], 1u); break; } }
    }
    nloc = mine > 0u ? mine : 1u; nx = cnt > 0u ? cnt : 1u;
}

__device__ __forceinline__ void xcd_barrier(const XcdBarrier& b) {
    asm volatile("s_waitcnt vmcnt(0)" ::: "memory");
    __syncthreads();
    if (threadIdx.x == 0) {
        unsigned* bar = b.bar;
        __builtin_amdgcn_s_waitcnt(0);
        unsigned nloc = b.st[0], nx = b.st[1];
        if (nloc == 0u) { xcd_barrier_complete(bar, b.x, nloc, nx); b.st[0] = nloc; b.st[1] = nx; }
        const unsigned old = xb_add(&bar[XB_XSUB(b.x)], 1u);
        const unsigned gen = old / nloc;
        if (old + 1u == (gen + 1u) * nloc) {
            __builtin_amdgcn_fence(__ATOMIC_RELEASE, "agent");
            asm volatile("s_waitcnt vmcnt(0)" ::: "memory");
            const unsigned og = xb_add(&bar[XB_TOP], 1u);
            const unsigned tg = og / nx;
            if (og + 1u == (tg + 1u) * nx) xb_add(&bar[XB_TOPGEN], 1u);
            else XB_SPIN(xb_ld(&bar[XB_TOPGEN]) == tg, bar);
            __builtin_amdgcn_fence(__ATOMIC_ACQUIRE, "agent");
            xb_add(&bar[XB_XGEN(b.x)], 1u);
            asm volatile("s_waitcnt vmcnt(0)" ::: "memory");
        } else {
            XB_SPIN(xb_ld(&bar[XB_XGEN(b.x)]) == gen, bar);
            __builtin_amdgcn_fence(__ATOMIC_ACQUIRE, "agent");
            asm volatile("s_waitcnt vmcnt(0)" ::: "memory");
        }
    }
    __syncthreads();
}

struct Args { const float* in[N_IN]; float* out; unsigned char* ws; int lo, hi; };

struct Ctx {
    LAS unsigned char* lds;
    int tid, lane, wave, vcu, G;
    const float* const* in; float* out; unsigned char* ws;
    unsigned* ctl;
};
#define WSP(T, off) ((T*)(C.ws + (off)))
__device__ __forceinline__ int seg_of_row(int row) { return row < TL ? (row >> 12) : 2; }
__device__ __forceinline__ const float* modp(const Ctx& C, int l, int s, int chunk) { return WSP(const float, WS_MOD) + ((size_t)(l * 3 + s) * 6 + chunk) * D; }

__device__ __forceinline__ void ph_ada(const Ctx& C) {
    LAS float* src = (LAS float*)C.lds;
    LAS float* red = (LAS float*)(C.lds + 32768);
    for (int i = C.tid; i < 3 * D; i += NTHREADS) { const int s = i / D, k = i % D; const float x = s < 2 ? C.in[I_C][s * D + k] : C.in[I_CCTX][k]; src[i] = siluf_(x); }
    __syncthreads();
    const int cq = C.tid & 31, kg = C.tid >> 5;
    for (int u = C.vcu; u < 2 * 96; u += C.G) {
        const int l = u / 96, c0 = (u % 96) * 128;
        const float* Wp = C.in[I_ADAW] + (size_t)l * D * (6 * D) + (size_t)(kg * 128) * (6 * D) + c0 + 4 * cq;
        f32x4 a0 = {0, 0, 0, 0}, a1 = a0, a2 = a0;
#pragma unroll 16
        for (int kk = 0; kk < 128; ++kk) {
            const f32x4 w = __builtin_nontemporal_load((const f32x4*)(Wp + (size_t)kk * (6 * D)));
            const int k = kg * 128 + kk;
            a0 += src[k] * w; a1 += src[D + k] * w; a2 += src[2 * D + k] * w;
        }
        *(LAS f32x4*)(red + (kg * 3 + 0) * 128 + 4 * cq) = a0;
        *(LAS f32x4*)(red + (kg * 3 + 1) * 128 + 4 * cq) = a1;
        *(LAS f32x4*)(red + (kg * 3 + 2) * 128 + 4 * cq) = a2;
        __syncthreads();
        if (C.tid < 384) {
            const int s = C.tid / 128, c = C.tid % 128; float v = C.in[I_ADAB][l * 6 * D + c0 + c];
#pragma unroll
            for (int g = 0; g < 16; ++g) v += red[(g * 3 + s) * 128 + c];
            WSP(float, WS_MOD)[(size_t)(l * 3 + s) * 6 * D + c0 + c] = v;
        }
        __syncthreads();
    }
}

__device__ __forceinline__ void load_row_f32(const float* p, int lane, f32x4 (&x)[8]) {
#pragma unroll
    for (int j = 0; j < 8; ++j) x[j] = *(const f32x4*)(p + 256 * j + 4 * lane);
}
template <bool F8> __device__ __forceinline__ void norm_mod_store(const f32x4 (&x)[8], int lane, LAS const float* va, LAS const float* vb, void* outrow) {
    float ss = 0.f;
#pragma unroll
    for (int j = 0; j < 8; ++j) ss += (x[j].x * x[j].x + x[j].y * x[j].y) + (x[j].z * x[j].z + x[j].w * x[j].w);
    const float rstd = rsqrtf(wave_sum(ss) * (1.0f / D) + EPS);
#pragma unroll
    for (int j = 0; j < 8; ++j) {
        const int k = 256 * j + 4 * lane;
        const f32x4 y = x[j] * rstd * *(LAS const f32x4*)(va + k) + *(LAS const f32x4*)(vb + k);
        if (F8) *(unsigned*)((unsigned char*)outrow + k) = pk4_fp8(y.x, y.y, y.z, y.w);
        else { u32x2 w; w.x = pk2(y.x, y.y); w.y = pk2(y.z, y.w); *(u32x2*)((bf16*)outrow + k) = w; }
    }
}

__device__ __forceinline__ void ph_norm0(const Ctx& C) {
    const int gw = C.vcu * NWAVES + C.wave, NGW = C.G * NWAVES;
    LAS float* VA = (LAS float*)C.lds; LAS float* VB = VA + 3 * D;
    for (int i = C.tid; i < 3 * (D / 4); i += NTHREADS) {
        const int sg = i / (D / 4), k = (i - sg * (D / 4)) * 4;
        *(LAS f32x4*)(VA + sg * D + k) = *(const f32x4*)(C.in[I_N1G] + k) * (1.0f + *(const f32x4*)(modp(C, 0, sg, 1) + k)); *(LAS f32x4*)(VB + sg * D + k) = *(const f32x4*)(modp(C, 0, sg, 0) + k);
    }
    __syncthreads();
    if (gw >= TT) return;
    f32x4 x[8], xn[8];
    { const float* p = gw < TL ? C.in[I_X] + (size_t)gw * D : C.in[I_CTX] + (size_t)(gw - TL) * D; load_row_f32(p, C.lane, x); }
    for (int row = gw; row < TT; row += NGW) {
        const int nrow = row + NGW;
        if (nrow < TT) { const float* p = nrow < TL ? C.in[I_X] + (size_t)nrow * D : C.in[I_CTX] + (size_t)(nrow - TL) * D; load_row_f32(p, C.lane, xn); }
        const int s = seg_of_row(row);
        norm_mod_store<F8_PW1>(x, C.lane, VA + s * D, VB + s * D, WSP(unsigned char, WS_XN0) + (size_t)row * D * (F8_PW1 ? 1 : 2));
#pragma unroll
        for (int j = 0; j < 8; ++j) x[j] = xn[j];
    }
}

struct CvtJob { const float* src; unsigned char* dst; int ld, K, cA, cB; };
__device__ __forceinline__ void cvt_job(const Ctx& C, int tile, CvtJob& j) {
    const int EB = (tile < 48 && dense_tile_f8(tile)) ? 1 : 2;
    if (tile < 16) { j.src = C.in[I_PW1W]; j.ld = 2 * D; j.K = EB * D; j.cA = tile * 128; j.cB = D + tile * 128; j.dst = WSP(unsigned char, WS_WPW1) + (size_t)tile * 256 * D * EB; }
    else if (tile < 24) { const int t = tile - 16; j.src = C.in[I_PW2W]; j.ld = D; j.K = EB * D; j.cA = t * 256; j.cB = j.cA + 128; j.dst = WSP(unsigned char, WS_WPW2) + (size_t)t * 256 * D * EB; }
    else if (tile < 40) { const int t = tile - 24; j.src = t < 8 ? C.in[I_WX] : C.in[I_WY]; j.ld = D; j.K = EB * D; j.cA = (t & 7) * 256; j.cB = j.cA + 128; j.dst = WSP(unsigned char, WS_WXY) + (size_t)t * 256 * D * EB; }
    else if (tile < 48) { const int t = tile - 40; j.src = C.in[I_WO]; j.ld = D; j.K = EB * D; j.cA = t * 256; j.cB = j.cA + 128; j.dst = WSP(unsigned char, WS_WWO) + (size_t)t * 256 * D * EB; }
    else if (tile < 48 + 512) { const int t = tile - 48, le = t >> 3, jt = t & 7; j.src = C.in[I_W1] + (size_t)le * D * (2 * FF); j.ld = 2 * FF; j.K = D; j.cA = jt * 128; j.cB = FF + jt * 128; j.dst = WSP(unsigned char, WS_WM1) + (size_t)t * 256 * D; }
    else { const int t = tile - 560, le = t >> 3, jt = t & 7; j.src = C.in[I_W2] + (size_t)le * FF * D; j.ld = D; j.K = FF; j.cA = jt * 256; j.cB = j.cA + 128; j.dst = WSP(unsigned char, WS_WM2) + (size_t)t * 256 * FF; }
}
constexpr int CVT_TLD = 144;
__device__ __forceinline__ void cvt_flush(const Ctx& C, LAS unsigned char* T, const u32x4 (&w)[4], const CvtJob& j, int kbyte0) {
#pragma unroll
    for (int i = 0; i < 4; ++i) *(LAS u32x4*)(T + (4 * C.lane + i) * CVT_TLD + 16 * C.wave) = w[i];
    __syncthreads();
#pragma unroll
    for (int i = 0; i < 4; ++i) {
        const int c = C.tid + 512 * i, r = c >> 3, pc = c & 7;
        const u32x4 v = *(const LAS u32x4*)(T + r * CVT_TLD + 16 * pc);
        __builtin_nontemporal_store(v, (u32x4*)(j.dst + (size_t)r * j.K + kbyte0 + 16 * pc));
    }
}
__host__ __device__ constexpr int dense_count(bool f8) { int n = 0; for (int t = 0; t < 48; ++t) n += dense_tile_f8(t) == f8 ? 1 : 0; return n; }
__device__ __forceinline__ int dense_tile_of(bool f8, int idx) { int t = 0; for (int n = 0; t < 48; ++t) { if (dense_tile_f8(t) == f8) { if (n == idx) break; ++n; } } return t; }
constexpr int CVT_ITEMS_BF = dense_count(false) * 32, CVT_ITEMS_D8 = dense_count(true) * 16;
__device__ __forceinline__ void cvtb_load(const Ctx& C, int it, f32x4 (&v)[8]) {
    const int tile = dense_tile_of(false, it >> 5), kc = it & 31; CvtJob j; cvt_job(C, tile, j);
    const int col = C.lane < 32 ? j.cA + 4 * C.lane : j.cB + 4 * (C.lane - 32);
    const float* p = j.src + (size_t)(kc * 64 + 8 * C.wave) * j.ld + col;
#pragma unroll
    for (int q = 0; q < 8; ++q) v[q] = *(const f32x4*)(p + (size_t)q * j.ld);
}
__device__ __forceinline__ void ph_convert_bf16(const Ctx& C) {
    int it = C.vcu; if (it >= CVT_ITEMS_BF) return;
    f32x4 va[8], vb[8];
    cvtb_load(C, it, va);
    int buf = 0;
    for (; it < CVT_ITEMS_BF; it += C.G) {
        const bool more = it + C.G < CVT_ITEMS_BF;
        if (more) cvtb_load(C, it + C.G, vb);
        u32x4 w[4];
#pragma unroll
        for (int i = 0; i < 4; ++i) { w[i].x = pk2(va[0][i], va[1][i]); w[i].y = pk2(va[2][i], va[3][i]); w[i].z = pk2(va[4][i], va[5][i]); w[i].w = pk2(va[6][i], va[7][i]); }
        CvtJob j; cvt_job(C, dense_tile_of(false, it >> 5), j);
        cvt_flush(C, C.lds + buf * (256 * CVT_TLD), w, j, (it & 31) * 128);
        buf ^= 1;
        if (more) {
#pragma unroll
            for (int q = 0; q < 8; ++q) va[q] = vb[q];
        }
    }
    __syncthreads();
}
constexpr int CVT_T0 = 48;
constexpr int CVT_ITEMS_W1 = (560 - CVT_T0) * 16, CVT_ITEMS_F8 = CVT_ITEMS_W1 + 512 * 8;
__device__ __forceinline__ void cvt8_decode(int it, int& tile, int& kc) { if (it < CVT_ITEMS_W1) { tile = CVT_T0 + (it >> 4); kc = it & 15; } else if (it < CVT_ITEMS_F8) { const int i2 = it - CVT_ITEMS_W1; tile = 560 + (i2 >> 3); kc = i2 & 7; }
    else { const int i3 = it - CVT_ITEMS_F8; tile = dense_tile_of(true, i3 >> 4); kc = i3 & 15; } }
__device__ __forceinline__ void cvt8_load(const Ctx& C, int it, f32x4 (&v)[16]) {
    int tile, kc; cvt8_decode(it, tile, kc); CvtJob j; cvt_job(C, tile, j);
    const int col = C.lane < 32 ? j.cA + 4 * C.lane : j.cB + 4 * (C.lane - 32);
    const float* p = j.src + (size_t)(kc * 128 + 16 * C.wave) * j.ld + col;
#pragma unroll
    for (int q = 0; q < 16; ++q) v[q] = __builtin_nontemporal_load((const f32x4*)(p + (size_t)q * j.ld));
}
constexpr int CVT_WL = 6144, CVT_DOFF = (48 - CVT_T0) * 16;
__device__ __forceinline__ int cvt8_item_of(int layer, int wi) { return layer == 2 ? CVT_ITEMS_F8 + wi : (wi < 4096 ? CVT_DOFF + layer * 4096 + wi : CVT_ITEMS_W1 + layer * 2048 + (wi - 4096)); }
__device__ __forceinline__ void cvt8_range(const Ctx& C, int layer, int wi_lo, int wi_hi, int rank, int nrank) {
    int wi = wi_lo + rank; if (wi >= wi_hi) return;
    f32x4 va[16], vb[16];
    cvt8_load(C, cvt8_item_of(layer, wi), va);
    int buf = 0;
    for (; wi < wi_hi; wi += nrank) {
        const bool more = wi + nrank < wi_hi;
        if (more) cvt8_load(C, cvt8_item_of(layer, wi + nrank), vb);
        u32x4 w[4];
#pragma unroll
        for (int i = 0; i < 4; ++i) {
            w[i].x = pk4_fp8(va[0][i] * W8_SCALE, va[1][i] * W8_SCALE, va[2][i] * W8_SCALE, va[3][i] * W8_SCALE);
            w[i].y = pk4_fp8(va[4][i] * W8_SCALE, va[5][i] * W8_SCALE, va[6][i] * W8_SCALE, va[7][i] * W8_SCALE);
            w[i].z = pk4_fp8(va[8][i] * W8_SCALE, va[9][i] * W8_SCALE, va[10][i] * W8_SCALE, va[11][i] * W8_SCALE);
            w[i].w = pk4_fp8(va[12][i] * W8_SCALE, va[13][i] * W8_SCALE, va[14][i] * W8_SCALE, va[15][i] * W8_SCALE);
        }
        int tile, kc; cvt8_decode(cvt8_item_of(layer, wi), tile, kc); CvtJob j; cvt_job(C, tile, j);
        cvt_flush(C, C.lds + buf * (256 * CVT_TLD), w, j, kc * 128);
        buf ^= 1;
        if (more) {
#pragma unroll
            for (int q = 0; q < 16; ++q) va[q] = vb[q];
        }
    }
    __syncthreads();
}
constexpr int CQ_PW1 = 38, CQ_PW2 = 24, CQ_WXY = 38, CQ_DWC = 8, CQ_RT0 = 16, CQ_ADA = 5;
constexpr int NU_DWC = (2048 + 2048 + 256) / 8, NU_RT0 = TT / 16;
constexpr int NU_PW1 = (TT / 256) * 16, NU_PW2 = (TT / 256) * 8, NU_WXY = (TT / 256) * 8 + (TL / 256) * 8;
__device__ __forceinline__ int gemm_width(int nunits, int G) { const int r = (nunits + G - 1) / G; int w = (nunits + r - 1) / r; w = (w + 8 - 1) / 8 * 8; return w < G ? w : G; }
__device__ __forceinline__ int cvt_share(int nunits, int G, int q) { return (G - gemm_width(nunits, G)) * q; }
__device__ __forceinline__ int imin(int a, int b) { return a < b ? a : b; }
__device__ __forceinline__ void cvt_side(const Ctx& C, int nunits, int q, int layer, int wi_lo) {
    const int W = gemm_width(nunits, C.G), c = (int)blockIdx.x;
    if (c < W) return;
    cvt8_range(C, layer, imin(wi_lo, CVT_WL), imin(wi_lo + (C.G - W) * q, CVT_WL), c - W, C.G - W);
}
__device__ __forceinline__ bool side_ctx(const Ctx& C, int nunits, Ctx& C2) {
    const int W = gemm_width(nunits, C.G), bx = (int)blockIdx.x;
    C2 = C; C2.G = W; C2.vcu = (W % 8 == 0) ? (bx % 8) * (W / 8) + bx / 8 : bx;
    return bx < W;
}
__device__ __forceinline__ void ph_convert_fp8(const Ctx& C) {
    const int n2 = cvt_share(NU_PW1, C.G, CQ_PW1) + cvt_share(NU_DWC, C.G, CQ_DWC), n5 = cvt_share(NU_PW2, C.G, CQ_PW2), n10 = cvt_share(NU_RT0, C.G, CQ_RT0) + cvt_share(NU_WXY, C.G, CQ_WXY);
    if (CVT_ITEMS_D8 > 0) cvt8_range(C, 2, 0, CVT_ITEMS_D8, C.vcu, C.G);
    cvt8_range(C, 0, imin(n2 + n5, CVT_WL), CVT_WL, C.vcu, C.G);
    const int nada = 2 * 96 < C.G ? 2 * 96 : C.G, nfree = C.G - nada;
    int lo1 = imin(n10, CVT_WL);
    if (nfree > 0) { const int pre = imin(nfree * CQ_ADA, CVT_WL - lo1); if (C.vcu >= nada) cvt8_range(C, 1, lo1, lo1 + pre, C.vcu - nada, nfree); lo1 += pre; }
    cvt8_range(C, 1, lo1, CVT_WL, C.vcu, C.G);
}

namespace pg8 {
constexpr int BM = 256, BK = 64, HALF = 128, HTB = HALF * BK * 2  , STAGE_BYTES = 8 * HTB, NXCD = 8, WGM = 8;
__device__ __forceinline__ int lds_byte(int r, int c) { const int st = (r >> 4) * 2 + (c >> 5), rr = r & 15, cc = c & 31, ob = rr * 64 + cc * 2; return st * 1024 + (ob ^ (((ob >> 9) & 1) << 5)); }
__device__ __forceinline__ void stage_rc(int b, int& R, int& C) { const int st = b / 1024, sb = b % 1024, swz = sb ^ (((sb >> 9) & 1) << 5); R = (st >> 1) * 16 + swz / 64; C = (st & 1) * 32 + (swz % 64) / 2; }
__device__ __forceinline__ int perm32(int rho) { const int n = rho >> 4, i = rho & 15; return 8 * (i >> 2) + 4 * n + (i & 3); }

struct Unit { int pm, pn; const char* a; const char* b; int x0, x1, x2; };

__device__ __forceinline__ void tile_order(int L, int nM, int nN, int& pm, int& pn) {
    const int nwg = nM * nN; int wgid = L; { const int q = nwg / NXCD, r = nwg % NXCD, xcd = wgid % NXCD, off = wgid / NXCD; wgid = (xcd < r ? xcd * (q + 1) : r * (q + 1) + (xcd - r) * q) + off; }
    const int nig = WGM * nN, gid = wgid / nig, fm = gid * WGM, gsz = (nM - fm) < WGM ? (nM - fm) : WGM;
    pm = fm + ((wgid % nig) % gsz); pn = (wgid % nig) / gsz;
}

typedef int i32x4v __attribute__((ext_vector_type(4)));
typedef int i32x8v __attribute__((ext_vector_type(8)));
template <bool FP8> __device__ __forceinline__ void mma_block(f32x4 (&acc)[4][2], const bf16x8 (&At)[4][2], const bf16x8 (&Bt)[2][2]) {
    if constexpr (FP8) {
#pragma unroll
        for (int m = 0; m < 4; ++m)
#pragma unroll
            for (int n = 0; n < 2; ++n) {
                const i32x8v b = __builtin_shufflevector(__builtin_bit_cast(i32x4v, Bt[n][0]), __builtin_bit_cast(i32x4v, Bt[n][1]), 0, 1, 2, 3, 4, 5, 6, 7);
                const i32x8v a = __builtin_shufflevector(__builtin_bit_cast(i32x4v, At[m][0]), __builtin_bit_cast(i32x4v, At[m][1]), 0, 1, 2, 3, 4, 5, 6, 7);
                acc[m][n] = __builtin_amdgcn_mfma_scale_f32_16x16x128_f8f6f4(b, a, acc[m][n], 0, 0, 0, 0x7F7F7F7F, 0, 0x7F7F7F7F);
            }
    } else {
#pragma unroll
        for (int m = 0; m < 4; ++m)
#pragma unroll
            for (int n = 0; n < 2; ++n)
#pragma unroll
                for (int k = 0; k < 2; ++k) acc[m][n] = __builtin_amdgcn_mfma_f32_16x16x32_bf16(Bt[n][k], At[m][k], acc[m][n], 0, 0, 0);
    }
}
template <class Epi, class Sched, bool ALIGN_EPI, bool FP8 = false>
__device__ __forceinline__ void gemm_phase(LAS unsigned char* lds, const int K, const Sched& S, const Epi& E) {
    const int tid = threadIdx.x, wid = __builtin_amdgcn_readfirstlane(tid >> 6), lane = tid & 63, wr = wid >> 2, wc = wid & 3, fr = lane & 15, fq = lane >> 4;
    const int nt = K / BK;
    int Rl[2], Cl[2]; unsigned voffA[2][2], voffB[2];
#pragma unroll
    for (int i = 0; i < 2; ++i) { stage_rc(tid * 16 + i * 8192, Rl[i], Cl[i]); const int Rb = Epi::PERM ? ((Rl[i] & ~31) + perm32(Rl[i] & 31)) : Rl[i]; voffB[i] = (unsigned)(Rb * K + Cl[i]) * 2u; }
    const size_t kstep = (size_t)(BK * 2);
    const size_t hstep = (size_t)HALF * K * 2;
    const unsigned ldsw = (unsigned)wid * 1024u;
    const int aoff = lds_byte(wr * 64 + fr, fq * 8), boff = lds_byte(wc * 32 + fr, fq * 8);
#define PG8_SA(b, h) (((b) * 2 + (h)) * HTB)
#define PG8_SB(b, h) ((4 + (b) * 2 + (h)) * HTB)
#define PG8_STAGE(bufoff, gbase, voff) do { _Pragma("unroll") for (int _i = 0; _i < 2; ++_i) { unsigned _v = (voff)[_i]; asm volatile("" : "+v"(_v));     \
        __builtin_amdgcn_global_load_lds((const unsigned*)((const char*)(gbase) + _v), (LAS unsigned*)(lds + (bufoff) + ldsw + _i * 8192), 16, 0, 0); } } while (0)
#define PG8_LDA(dst, b, h) do { _Pragma("unroll") for (int m = 0; m < 4; ++m) _Pragma("unroll") for (int k = 0; k < 2; ++k) dst[m][k] = *(const LAS bf16x8*)(lds + PG8_SA(b, h) + aoff + m * 2048 + k * 1024); } while (0)
#define PG8_LDB(dst, b, h) do { _Pragma("unroll") for (int n = 0; n < 2; ++n) _Pragma("unroll") for (int k = 0; k < 2; ++k) dst[n][k] = *(const LAS bf16x8*)(lds + PG8_SB(b, h) + boff + n * 2048 + k * 1024); } while (0)
#define PG8_MMA(ai, bj, At, Bt) do { __builtin_amdgcn_s_setprio(1); mma_block<FP8>(acc[ai][bj], At, Bt); __builtin_amdgcn_s_setprio(0); } while (0)
#define PG8_WAIT_V(n) asm volatile("s_waitcnt vmcnt(" #n ")" ::: "memory")
#define PG8_WAIT_L(n) asm volatile("s_waitcnt lgkmcnt(" #n ")" ::: "memory")
#define PG8_BAR __builtin_amdgcn_s_barrier()
#define PG8_SCHED __builtin_amdgcn_sched_barrier(0)
    Unit cur, nxt; int ui = 0;
    if (!S.next(0, cur)) return;
    f32x4 acc[2][2][4][2];
#pragma unroll
    for (int a = 0; a < 2; ++a)
#pragma unroll
        for (int b = 0; b < 2; ++b)
#pragma unroll
            for (int m = 0; m < 4; ++m)
#pragma unroll
                for (int n = 0; n < 2; ++n) acc[a][b][m][n] = (f32x4){0.f, 0.f, 0.f, 0.f};
    bf16x8 At[4][2], B0[2][2], B1[2][2];
    const char* cA = cur.a; const char* cB = cur.b;
    S.first_offsets(cur, K, Rl, Cl, voffA);
    PG8_STAGE(PG8_SB(0, 0), cB, voffB); PG8_STAGE(PG8_SB(0, 1), cB + hstep, voffB); PG8_STAGE(PG8_SA(0, 0), cA, voffA[0]); PG8_STAGE(PG8_SA(0, 1), cA, voffA[1]);
    if (wr == 1) PG8_BAR;
    PG8_WAIT_V(2); PG8_BAR;
    PG8_STAGE(PG8_SB(1, 0), cB + kstep, voffB); PG8_STAGE(PG8_SA(1, 0), cA + kstep, voffA[0]); PG8_STAGE(PG8_SB(1, 1), cB + hstep + kstep, voffB);
    PG8_WAIT_V(6); PG8_BAR;
    for (;;) {
        const bool has_next = S.next(ui + 1, nxt);
        const char* nA = has_next ? nxt.a : cA; const char* nB = has_next ? nxt.b : cB;
        if (has_next) S.prefetch_next(nxt, ui + 1, lds, wid, lane);
        E.prefetch(cur, ui, lds, wid, lane);
#pragma unroll 1
        for (int t = 0; t < nt; t += 2) {
            const bool last = (t == nt - 2);
            const char* a1 = cA + (size_t)(t + 1) * kstep;
            const char* a2 = last ? nA : cA + (size_t)(t + 2) * kstep; const char* b2 = last ? nB : cB + (size_t)(t + 2) * kstep;
            const char* a3 = a2 + kstep; const char* b3 = b2 + kstep;
            PG8_LDB(B0, 0, 0); PG8_LDB(B1, 0, 1); PG8_SCHED; PG8_LDA(At, 0, 0); PG8_STAGE(PG8_SA(1, 1), a1, voffA[1]);
            if (last && has_next) S.next_offsets(nxt, ui + 1, K, Rl, Cl, lds, voffA);
            PG8_WAIT_V(8); PG8_WAIT_L(0); PG8_BAR; PG8_MMA(0, 0, At, B0); PG8_MMA(0, 1, At, B1); PG8_BAR; PG8_SCHED;
            PG8_LDA(At, 0, 1); PG8_STAGE(PG8_SB(0, 0), b2, voffB); PG8_STAGE(PG8_SB(0, 1), b2 + hstep, voffB); PG8_STAGE(PG8_SA(0, 0), a2, voffA[0]);
            PG8_WAIT_V(8); PG8_WAIT_L(0); PG8_BAR; PG8_MMA(1, 0, At, B0); PG8_MMA(1, 1, At, B1); PG8_BAR; PG8_SCHED;
            PG8_LDB(B0, 1, 0); PG8_LDB(B1, 1, 1); PG8_SCHED; PG8_LDA(At, 1, 0); PG8_STAGE(PG8_SA(0, 1), a2, voffA[1]);
            PG8_WAIT_V(8); PG8_WAIT_L(0); PG8_BAR; PG8_MMA(0, 0, At, B0); PG8_MMA(0, 1, At, B1); PG8_BAR; PG8_SCHED;
            PG8_LDA(At, 1, 1); PG8_STAGE(PG8_SB(1, 0), b3, voffB); PG8_STAGE(PG8_SB(1, 1), b3 + hstep, voffB); PG8_STAGE(PG8_SA(1, 0), a3, voffA[0]);
            PG8_WAIT_V(8); PG8_WAIT_L(0); PG8_BAR; PG8_MMA(1, 0, At, B0); PG8_MMA(1, 1, At, B1); PG8_BAR; PG8_SCHED;
        }
        if constexpr (ALIGN_EPI) { if (wr == 0) PG8_BAR; }
        { int tz = threadIdx.x; asm volatile("" : "+v"(tz));
          const int lane2 = tz & 63; E(acc, cur, wr, wc, lane2 & 15, lane2 >> 4, lds, ui); }
        if (!has_next) break;
#pragma unroll
        for (int a = 0; a < 2; ++a)
#pragma unroll
            for (int b = 0; b < 2; ++b)
#pragma unroll
                for (int m = 0; m < 4; ++m)
#pragma unroll
                    for (int n = 0; n < 2; ++n) acc[a][b][m][n] = (f32x4){0.f, 0.f, 0.f, 0.f};
        cur = nxt; cA = nA; cB = nB; ++ui;
        if constexpr (ALIGN_EPI) { if (wr == 1) PG8_BAR; }
    }
    PG8_WAIT_V(0);
    if constexpr (!ALIGN_EPI) { if (wr == 0) PG8_BAR; }
    PG8_BAR;
#undef PG8_SA
#undef PG8_SB
#undef PG8_STAGE
#undef PG8_LDA
#undef PG8_LDB
#undef PG8_MMA
#undef PG8_WAIT_V
#undef PG8_WAIT_L
#undef PG8_BAR
#undef PG8_SCHED
}

struct DenseBase {
    __device__ __forceinline__ void first_offsets(const Unit& u, int K, const int (&Rl)[2], const int (&Cl)[2], unsigned (&voffA)[2][2]) const {
#pragma unroll
        for (int h = 0; h < 2; ++h)
#pragma unroll
            for (int i = 0; i < 2; ++i) voffA[h][i] = (unsigned)((u.pm * BM + h * HALF + Rl[i]) * K + Cl[i]) * 2u;
    }
    __device__ __forceinline__ void prefetch_next(const Unit&, int, LAS unsigned char*, int, int) const {}
    __device__ __forceinline__ void next_offsets(const Unit& n, int, int K, const int (&Rl)[2], const int (&Cl)[2], LAS unsigned char*, unsigned (&voffA)[2][2]) const {
#pragma unroll
        for (int h = 0; h < 2; ++h)
#pragma unroll
            for (int i = 0; i < 2; ++i) voffA[h][i] = (unsigned)((n.pm * BM + h * HALF + Rl[i]) * K + Cl[i]) * 2u;
    }
};
struct DenseOrder : DenseBase {
    const char* A; const char* B; int nM, nN, G, c, K;
    __device__ __forceinline__ bool next(int i, Unit& u) const {
        const long L = (long)i * G + c; if (L >= (long)nM * nN) return false;
        tile_order((int)L, nM, nN, u.pm, u.pn);
        u.a = A; u.b = B + (size_t)u.pn * BM * K * 2; u.x0 = u.x1 = u.x2 = 0; return true;
    }
};
struct WxyOrder : DenseBase {
    const char* A; const char* B; int G, c, K;
    __device__ __forceinline__ bool next(int i, Unit& u) const {
        const long L = (long)i * G + c; constexpr int NXU = (TT / 256) * 8, NYU = (TL / 256) * 8; if (L >= NXU + NYU) return false;
        if (L < NXU) { tile_order((int)L, TT / 256, 8, u.pm, u.pn); } else { tile_order((int)L - NXU, TL / 256, 8, u.pm, u.pn); u.pn += 8; }
        u.a = A; u.b = B + (size_t)u.pn * BM * K * 2; u.x0 = u.x1 = u.x2 = 0; return true;
    }
};
constexpr int MOE_TAB_OFF = LDS_MISC + 1024, MOE_IDX_OFF = LDS_MISC + 2048;
__device__ __forceinline__ bool moe_decode(LAS const int* tab, long L, int NNT, int& ehint, int& e, int& mt, int& nt) {
    const int nwg = __builtin_amdgcn_readfirstlane(tab[64]) * NNT; if (L >= nwg) return false;
    int w = (int)L; { const int q = nwg / NXCD, r = nwg % NXCD, xcd = w % NXCD, off = w / NXCD; w = (xcd < r ? xcd * (q + 1) : r * (q + 1) + (xcd - r) * q) + off; }
    e = ehint; while (e < NE - 1 && w >= __builtin_amdgcn_readfirstlane(tab[32 + e + 1]) * NNT) ++e;
    ehint = e;
    const int t0 = __builtin_amdgcn_readfirstlane(tab[32 + e]), t1 = __builtin_amdgcn_readfirstlane(tab[32 + e + 1]);
    const int wl = w - t0 * NNT, te = t1 - t0;
    nt = wl / te; mt = wl - nt * te; return true;
}
struct Moe1Order {
    const char* FN; const char* W; const int* list; LAS const int* tab; int G, c; mutable int ehint;
    __device__ __forceinline__ bool next(int i, Unit& u) const {
        int e, mt, nt; if (!moe_decode(tab, (long)i * G + c, 8, ehint, e, mt, nt)) return false;
        u.pm = __builtin_amdgcn_readfirstlane(tab[32 + e]) + mt; u.pn = nt; u.x0 = e; u.x1 = mt; u.x2 = __builtin_amdgcn_readfirstlane(tab[e]);
        u.a = FN; u.b = W + ((size_t)e * 8 + nt) * BM * D; return true;
    }
    __device__ __forceinline__ void first_offsets(const Unit& u, int K, const int (&Rl)[2], const int (&Cl)[2], unsigned (&voffA)[2][2]) const {
        const int* le = list + (size_t)u.x0 * LCAP + u.x1 * 256;
#pragma unroll
        for (int h = 0; h < 2; ++h)
#pragma unroll
            for (int i = 0; i < 2; ++i) { const int r = h * HALF + Rl[i]; const int tok = (u.x1 * 256 + r < u.x2) ? (le[r] >> 2) : 0; voffA[h][i] = (unsigned)(tok * K + Cl[i]) * 2u; }
    }
    __device__ __forceinline__ void prefetch_next(const Unit& n, int ui, LAS unsigned char* lds, int wid, int lane) const {
        if (wid < 4) { const int* src = list + (size_t)n.x0 * LCAP + n.x1 * 256 + wid * 64 + lane;
            __builtin_amdgcn_global_load_lds((const unsigned*)src, (LAS unsigned*)(lds + MOE_IDX_OFF + (ui & 1) * 1024 + wid * 256), 4, 0, 0); }
    }
    __device__ __forceinline__ void next_offsets(const Unit& n, int ui, int K, const int (&Rl)[2], const int (&Cl)[2], LAS unsigned char* lds, unsigned (&voffA)[2][2]) const {
        LAS const int* idx = (LAS const int*)(lds + MOE_IDX_OFF + (ui & 1) * 1024);
#pragma unroll
        for (int h = 0; h < 2; ++h)
#pragma unroll
            for (int i = 0; i < 2; ++i) { const int r = h * HALF + Rl[i]; const int v = idx[r]; const int tok = (n.x1 * 256 + r < n.x2) ? (v >> 2) : 0; voffA[h][i] = (unsigned)(tok * K + Cl[i]) * 2u; }
    }
};
struct Moe2Order {
    const char* ACT; const char* W; LAS const int* tab; int G, c; mutable int ehint;
    __device__ __forceinline__ bool next(int i, Unit& u) const {
        int e, mt, nt; if (!moe_decode(tab, (long)i * G + c, 8, ehint, e, mt, nt)) return false;
        u.pm = __builtin_amdgcn_readfirstlane(tab[32 + e]) + mt; u.pn = nt; u.x0 = e; u.x1 = mt; u.x2 = __builtin_amdgcn_readfirstlane(tab[e]);
        u.a = ACT; u.b = W + ((size_t)e * 8 + nt) * BM * FF; return true;
    }
    __device__ __forceinline__ void first_offsets(const Unit& u, int K, const int (&Rl)[2], const int (&Cl)[2], unsigned (&voffA)[2][2]) const {
#pragma unroll
        for (int h = 0; h < 2; ++h)
#pragma unroll
            for (int i = 0; i < 2; ++i) voffA[h][i] = (unsigned)((u.pm * BM + h * HALF + Rl[i]) * K + Cl[i]) * 2u;
    }
    __device__ __forceinline__ void prefetch_next(const Unit&, int, LAS unsigned char*, int, int) const {}
    __device__ __forceinline__ void next_offsets(const Unit& n, int, int K, const int (&Rl)[2], const int (&Cl)[2], LAS unsigned char*, unsigned (&voffA)[2][2]) const {
#pragma unroll
        for (int h = 0; h < 2; ++h)
#pragma unroll
            for (int i = 0; i < 2; ++i) voffA[h][i] = (unsigned)((n.pm * BM + h * HALF + Rl[i]) * K + Cl[i]) * 2u;
    }
};
}

__device__ __forceinline__ int seg_of_tile(int pm) { return pm < 16 ? 0 : (pm < 32 ? 1 : 2); }
__device__ __forceinline__ void ep_dma(LAS unsigned char* lds, int ui, int word_off, const void* src_word0, int wid, int lane) {
    __builtin_amdgcn_global_load_lds((const unsigned*)src_word0 + wid * 64 + lane, (LAS unsigned*)(lds + LDS_EP + (ui & 1) * 4096 + (word_off + wid * 64) * 4), 4, 0, 0);
}
template <int MODE  > struct EpiGlu {
    static constexpr bool PERM = true;
    bf16* O; int ldo; const float* Bv; const float* Bg; int bstride; float asc;
    __device__ __forceinline__ void prefetch(const pg8::Unit& u, int ui, LAS unsigned char* lds, int wid, int lane) const {
        if (wid < 4) { const float* src = (wid < 2 ? Bv : Bg) + (size_t)u.x0 * bstride + u.pn * 128 - (wid < 2 ? 0 : 128); ep_dma(lds, ui, 0, src, wid, lane); }
    }
    __device__ __forceinline__ void operator()(const f32x4 (&acc)[2][2][4][2], const pg8::Unit& u, int wr, int wc, int fr, int fq, LAS unsigned char* lds, int ui) const {
        const int row0 = u.pm * 256 + wr * 64 + fr, cl = wc * 32 + 8 * fq, col0 = u.pn * 128 + cl;
        LAS const float* P = (LAS const float*)(lds + LDS_EP + (ui & 1) * 4096);
        const f32x4 bv0 = *(LAS const f32x4*)(P + cl), bv1 = *(LAS const f32x4*)(P + cl + 4), bg0 = *(LAS const f32x4*)(P + 128 + cl), bg1 = *(LAS const f32x4*)(P + 128 + cl + 4);
        const float sc = asc;
#pragma unroll
        for (int ai = 0; ai < 2; ++ai)
#pragma unroll
            for (int m = 0; m < 4; ++m) {
                const f32x4 a0 = acc[ai][0][m][0] * sc + bv0, a1 = acc[ai][0][m][1] * sc + bv1, g0 = acc[ai][1][m][0] * sc + bg0, g1 = acc[ai][1][m][1] * sc + bg1;
                float o[8];
                if (MODE == 0) {
#pragma unroll
                    for (int i = 0; i < 4; ++i) { o[i] = a0[i] * sigmoidf_(g0[i]); o[4 + i] = a1[i] * sigmoidf_(g1[i]); }
                } else {
#pragma unroll
                    for (int i = 0; i < 4; i += 2) {
#pragma unroll
                        for (int hf = 0; hf < 2; ++hf) {
                            const f32x4& av = hf ? a1 : a0; const f32x4& gv = hf ? g1 : g0;
                            f32x2 x = {fminf(av[i], 7.0f), fminf(av[i + 1], 7.0f)};
                            f32x2 y = {fminf(fmaxf(gv[i], -7.0f), 7.0f), fminf(fmaxf(gv[i + 1], -7.0f), 7.0f)};
                            const f32x2 t = x * (-1.702f * 1.4426950408889634f);
                            f32x2 e; e.x = __builtin_amdgcn_exp2f(t.x); e.y = __builtin_amdgcn_exp2f(t.y);
                            e = e + 1.0f;
                            f32x2 r; r.x = __builtin_amdgcn_rcpf(e.x); r.y = __builtin_amdgcn_rcpf(e.y);
                            const f32x2 ov = (x * (y + 1.0f)) * r;
                            o[4 * hf + i] = ov.x; o[4 * hf + i + 1] = ov.y;
                        }
                    }
                }
                if (MODE == 0) {
                    u32x4 w; w.x = pk2(o[0], o[1]); w.y = pk2(o[2], o[3]); w.z = pk2(o[4], o[5]); w.w = pk2(o[6], o[7]);
                    *(u32x4*)(O + (size_t)(row0 + ai * 128 + m * 16) * ldo + col0) = w;
                } else {
                    u32x2 w; w.x = pk4_fp8(o[0], o[1], o[2], o[3]); w.y = pk4_fp8(o[4], o[5], o[6], o[7]);
                    *(u32x2*)((unsigned char*)O + (size_t)(row0 + ai * 128 + m * 16) * ldo + col0) = w;
                }
            }
    }
};
struct EpiDelta {
    static constexpr bool PERM = true;
    bf16* O; const float* bias; const float* gate; float asc;
    __device__ __forceinline__ void prefetch(const pg8::Unit& u, int ui, LAS unsigned char* lds, int wid, int lane) const {
        const float* src = wid < 4 ? bias + u.pn * 256 : gate + (size_t)seg_of_tile(u.pm) * 6 * D + u.pn * 256 - 256; ep_dma(lds, ui, 0, src, wid, lane);
    }
    __device__ __forceinline__ void operator()(const f32x4 (&acc)[2][2][4][2], const pg8::Unit& u, int wr, int wc, int fr, int fq, LAS unsigned char* lds, int ui) const {
        const int row0 = u.pm * 256 + wr * 64 + fr, cl = wc * 32 + 8 * fq, col0 = u.pn * 256 + cl;
        LAS const float* P = (LAS const float*)(lds + LDS_EP + (ui & 1) * 4096);
        f32x4 bv[2][2], gv[2][2];
#pragma unroll
        for (int bj = 0; bj < 2; ++bj)
#pragma unroll
            for (int n = 0; n < 2; ++n) { bv[bj][n] = *(LAS const f32x4*)(P + cl + bj * 128 + 4 * n); gv[bj][n] = *(LAS const f32x4*)(P + 256 + cl + bj * 128 + 4 * n); }
#pragma unroll
        for (int ai = 0; ai < 2; ++ai)
#pragma unroll
            for (int m = 0; m < 4; ++m)
#pragma unroll
                for (int bj = 0; bj < 2; ++bj) {
                    const f32x4 v0 = gv[bj][0] * (acc[ai][bj][m][0] * asc + bv[bj][0]), v1 = gv[bj][1] * (acc[ai][bj][m][1] * asc + bv[bj][1]);
                    u32x4 w; w.x = pk2(v0[0], v0[1]); w.y = pk2(v0[2], v0[3]); w.z = pk2(v1[0], v1[1]); w.w = pk2(v1[2], v1[3]);
                    *(u32x4*)(O + (size_t)(row0 + ai * 128 + m * 16) * D + col0 + bj * 128) = w;
                }
    }
};
struct EpiWxy {
    static constexpr bool PERM = true;
    bf16* XB; bf16* YL; const float* bx; const float* by; float asc;
    __device__ __forceinline__ void prefetch(const pg8::Unit& u, int ui, LAS unsigned char* lds, int wid, int lane) const {
        if (wid < 4) ep_dma(lds, ui, 0, (u.pn >= 8 ? by : bx) + (u.pn & 7) * 256, wid, lane);
    }
    __device__ __forceinline__ void operator()(const f32x4 (&acc)[2][2][4][2], const pg8::Unit& u, int wr, int wc, int fr, int fq, LAS unsigned char* lds, int ui) const {
        const bool isy = u.pn >= 8; const int pn = u.pn & 7; bf16* O = isy ? YL : XB;
        const int row0 = u.pm * 256 + wr * 64 + fr, cl = wc * 32 + 8 * fq, col0 = pn * 256 + cl;
        LAS const float* P = (LAS const float*)(lds + LDS_EP + (ui & 1) * 4096);
        f32x4 bv[2][2];
#pragma unroll
        for (int bj = 0; bj < 2; ++bj)
#pragma unroll
            for (int n = 0; n < 2; ++n) bv[bj][n] = *(LAS const f32x4*)(P + cl + bj * 128 + 4 * n);
#pragma unroll
        for (int ai = 0; ai < 2; ++ai)
#pragma unroll
            for (int m = 0; m < 4; ++m)
#pragma unroll
                for (int bj = 0; bj < 2; ++bj) {
                    f32x4 v0 = acc[ai][bj][m][0] * asc + bv[bj][0], v1 = acc[ai][bj][m][1] * asc + bv[bj][1];
                    if (isy) {
#pragma unroll
                        for (int i = 0; i < 4; ++i) { v0[i] = gelu_tanh(v0[i]); v1[i] = gelu_tanh(v1[i]); } }
                    u32x4 w; w.x = pk2(v0[0], v0[1]); w.y = pk2(v0[2], v0[3]); w.z = pk2(v1[0], v1[1]); w.w = pk2(v1[2], v1[3]);
                    *(u32x4*)(O + (size_t)(row0 + ai * 128 + m * 16) * D + col0 + bj * 128) = w;
                }
    }
};
struct EpiMoe2 {
    static constexpr bool PERM = true;
    bf16* Y; const float* B2; const int* list; const float* plist;
    __device__ __forceinline__ void prefetch(const pg8::Unit& u, int ui, LAS unsigned char* lds, int wid, int lane) const {
        const size_t lo = (size_t)u.x0 * LCAP + u.x1 * 256;
        if (wid < 4) { ep_dma(lds, ui, 0, B2 + (size_t)u.x0 * D + u.pn * 256, wid, lane); ep_dma(lds, ui, 512, plist + lo, wid, lane); }
        else ep_dma(lds, ui, 0, list + lo - 256, wid, lane);
    }
    static constexpr int XT_OFF = 131072, XT_LD = 272, XT_BUF = 32 * XT_LD;
    __device__ __forceinline__ void operator()(const f32x4 (&acc)[2][2][4][2], const pg8::Unit& u, int wr, int wc, int fr, int fq, LAS unsigned char* lds, int ui) const {
        const int nvalid = u.x2 - u.x1 * 256;
        const int cl = wc * 32 + 8 * fq;
        LAS const float* P = (LAS const float*)(lds + LDS_EP + (ui & 1) * 4096); LAS const int* SL = (LAS const int*)(P + 256); LAS const float* PL = P + 512;
        f32x4 bv[2][2];
#pragma unroll
        for (int bj = 0; bj < 2; ++bj)
#pragma unroll
            for (int n = 0; n < 2; ++n) bv[bj][n] = *(LAS const f32x4*)(P + cl + bj * 128 + 4 * n);
        const int lane = fq * 16 + fr, wid = wr * 4 + wc;
        const int r2 = 4 * wid + (lane >> 4), c2 = (lane & 15) * 16;
        const int rt2 = (r2 >> 4) * 64 + (r2 & 15);
        unsigned char* yb = (unsigned char*)Y + u.pn * 256 + c2;
#pragma unroll
        for (int ai = 0; ai < 2; ++ai)
#pragma unroll
            for (int m = 0; m < 4; ++m) {
                LAS unsigned char* xt = lds + XT_OFF + ((ai * 4 + m) & 1) * XT_BUF;
                const int r = ai * 128 + wr * 64 + m * 16 + fr;
                const float p = r < nvalid ? PL[r] : 0.0f;
#pragma unroll
                for (int bj = 0; bj < 2; ++bj) {
                    const f32x4 v0 = (acc[ai][bj][m][0] * W8_INV + bv[bj][0]) * p, v1 = (acc[ai][bj][m][1] * W8_INV + bv[bj][1]) * p;
                    u32x2 w; w.x = pk4_fp8(v0[0], v0[1], v0[2], v0[3]); w.y = pk4_fp8(v1[0], v1[1], v1[2], v1[3]);
                    *(LAS u32x2*)(xt + (wr * 16 + fr) * XT_LD + bj * 128 + cl) = w;
                }
                asm volatile("s_waitcnt lgkmcnt(0)" ::: "memory"); __builtin_amdgcn_s_barrier();
                const int rt = ai * 128 + m * 16 + rt2;
                const int slot = rt < nvalid ? SL[rt] : TT * 4 + (((int)blockIdx.x * 8 + ai * 4 + m + r2 * 8) & 1023);
                const u32x4 v = *(LAS const u32x4*)(xt + r2 * XT_LD + c2);
                *(u32x4*)(yb + (size_t)slot * D) = v;
            }
    }
};

__device__ __forceinline__ void ph_pw1(const Ctx& C) {
    pg8::DenseOrder S; S.A = (const char*)WSP(const bf16, WS_XN0); S.B = (const char*)WSP(const bf16, WS_WPW1); S.nM = TT / 256; S.nN = 16; S.G = gemm_width(NU_PW1, C.G); S.c = (int)blockIdx.x; S.K = F8_PW1 ? D / 2 : D;
    EpiGlu<0> E{WSP(bf16, WS_V), D, C.in[I_PW1B], C.in[I_PW1B] + D, 0, F8_PW1 ? W8_INV : 1.0f};
    if (S.c < S.G) pg8::gemm_phase<EpiGlu<0>, pg8::DenseOrder, true, F8_PW1>(C.lds, F8_PW1 ? D / 2 : D, S, E);
    cvt_side(C, NU_PW1, CQ_PW1, 0, 0);
}
__device__ __forceinline__ void ph_pw2(const Ctx& C) {
    pg8::DenseOrder S; S.A = (const char*)WSP(const bf16, WS_A2); S.B = (const char*)WSP(const bf16, WS_WPW2); S.nM = TT / 256; S.nN = 8; S.G = gemm_width(NU_PW2, C.G); S.c = (int)blockIdx.x; S.K = F8_PW2 ? D / 2 : D;
    EpiDelta E{WSP(bf16, WS_DELTA), C.in[I_PW2B], modp(C, 0, 0, 2), F8_PW2 ? W8_INV : 1.0f};
    if (S.c < S.G) pg8::gemm_phase<EpiDelta, pg8::DenseOrder, true, F8_PW2>(C.lds, F8_PW2 ? D / 2 : D, S, E);
    cvt_side(C, NU_PW2, CQ_PW2, 0, cvt_share(NU_PW1, C.G, CQ_PW1) + cvt_share(NU_DWC, C.G, CQ_DWC));
}
__device__ __forceinline__ void moe_table(const Ctx& C, int layer, LAS int* tab) {
    if (C.tid < 64) {
        const int e = C.lane & 31;
        const int c = (int)__hip_atomic_load(C.ctl + CW_CNT + layer * 64 + e, __ATOMIC_RELAXED, __HIP_MEMORY_SCOPE_AGENT);
        const int tiles = (c + TM - 1) / TM; int incl = tiles;
#pragma unroll
        for (int o = 1; o < 32; o <<= 1) { const int v = __shfl_up(incl, o, 32); if (e >= o) incl += v; }
        if (C.lane < 32) { tab[e] = c; tab[32 + e] = incl - tiles; if (e == 31) tab[64] = incl; }
    }
    __syncthreads();
}
__device__ __forceinline__ void ph_moe1(const Ctx& C, int layer, const bf16* FN, bf16* ACT) {
    LAS int* tab = (LAS int*)(C.lds + pg8::MOE_TAB_OFF);
    moe_table(C, layer, tab);
    pg8::Moe1Order S; S.FN = (const char*)FN; S.W = (const char*)(WSP(const unsigned char, WS_WM1) + (size_t)layer * NE * 2 * FF * D);
    S.list = WSP(const int, WS_LIST) + (size_t)layer * NE * LCAP; S.tab = tab; S.G = C.G; S.c = (int)blockIdx.x; S.ehint = 0;
    const float* B1 = C.in[I_B1] + (size_t)layer * NE * 2 * FF;
    EpiGlu<1> E{ACT, FF, B1, B1 + FF, 2 * FF, W8_INV};
    pg8::gemm_phase<EpiGlu<1>, pg8::Moe1Order, true, true>(C.lds, D / 2, S, E);
}
__device__ __forceinline__ void ph_moe2(const Ctx& C, int layer, const bf16* ACT, bf16* Y) {
    LAS int* tab = (LAS int*)(C.lds + pg8::MOE_TAB_OFF);
    moe_table(C, layer, tab);
    pg8::Moe2Order S; S.ACT = (const char*)ACT; S.W = (const char*)(WSP(const unsigned char, WS_WM2) + (size_t)layer * NE * D * FF); S.tab = tab; S.G = C.G; S.c = (int)blockIdx.x; S.ehint = 0;
    EpiMoe2 E{Y, C.in[I_B2] + (size_t)layer * NE * D, WSP(const int, WS_LIST) + (size_t)layer * NE * LCAP, WSP(const float, WS_PLIST) + (size_t)layer * NE * LCAP};
    pg8::gemm_phase<EpiMoe2, pg8::Moe2Order, true, true>(C.lds, FF / 2, S, E);
}
__device__ __forceinline__ void ph_wxy(const Ctx& C) {
    pg8::WxyOrder S; S.A = (const char*)WSP(const bf16, WS_XN1); S.B = (const char*)WSP(const bf16, WS_WXY); S.G = gemm_width(NU_WXY, C.G); S.c = (int)blockIdx.x; S.K = F8_WXY ? D / 2 : D;
    EpiWxy E{WSP(bf16, WS_XB), WSP(bf16, WS_YL), C.in[I_BX], C.in[I_BY], F8_WXY ? W8_INV : 1.0f};
    if (S.c < S.G) pg8::gemm_phase<EpiWxy, pg8::WxyOrder, true, F8_WXY>(C.lds, F8_WXY ? D / 2 : D, S, E);
    cvt_side(C, NU_WXY, CQ_WXY, 1, cvt_share(NU_RT0, C.G, CQ_RT0));
}
__device__ __forceinline__ void ph_wo(const Ctx& C) {
    pg8::DenseOrder S; S.A = (const char*)WSP(const bf16, WS_Z); S.B = (const char*)WSP(const bf16, WS_WWO); S.nM = TL / 256; S.nN = 8; S.G = C.G; S.c = (int)blockIdx.x; S.K = F8_WO ? D / 2 : D;
    EpiDelta E{WSP(bf16, WS_DELTA), C.in[I_BO], modp(C, 1, 0, 2), F8_WO ? W8_INV : 1.0f};
    pg8::gemm_phase<EpiDelta, pg8::DenseOrder, true, F8_WO>(C.lds, F8_WO ? D / 2 : D, S, E);
}

__device__ __forceinline__ void ph_dwconv(const Ctx& C) {
    const bf16* V = WSP(const bf16, WS_V); bf16* CV = WSP(bf16, WS_CV);
    const float* Wt = C.in[I_DWW]; const float* Bi = C.in[I_DWB];
    const int gw = C.vcu * NWAVES + C.wave, NGW = C.G * NWAVES;
    LAS unsigned char* T = C.lds + C.wave * 16384;
    constexpr int NTASK = 2048 + 2048 + 256;
    for (int task = gw; task < NTASK; task += NGW) {
        int tb, ps, pbase, L, ch0;
        if (task < 2048) { const int hf = task & 1, cg = (task >> 1) & 7, sq = task >> 4; tb = sq * 64; ps = 1; pbase = hf * 32; L = 64; ch0 = cg * 128; }
        else if (task < 4096) { const int i2 = task - 2048, hf = i2 & 1, cg = (i2 >> 1) & 7, cid = i2 >> 4; tb = (cid >> 6) * SEQ + (cid & 63); ps = 64; pbase = hf * 32; L = 64; ch0 = 1024 + cg * 128; }
        else { const int i3 = task - 4096, cg = i3 & 15, sp = i3 >> 4; tb = TL + (sp >> 3) * CTXL; ps = 1; pbase = (sp & 7) * 32; L = CTXL; ch0 = cg * 128; }
#pragma unroll
        for (int i = 0; i < 16; ++i) {
            int p = pbase - CONVP + 4 * i + (C.lane >> 4); p = p < 0 ? 0 : (p >= L ? L - 1 : p);
            const bf16* src = V + (size_t)(tb + p * ps) * D + ch0 + (C.lane & 15) * 8;
            __builtin_amdgcn_global_load_lds((const unsigned*)src, (LAS unsigned*)(T + i * 1024), 16, 0, 0);
        }
        const int ch = ch0 + 2 * C.lane;
        float w0[CONVK], w1[CONVK];
#pragma unroll
        for (int j = 0; j < CONVK; ++j) { const f32x2 w = *(const f32x2*)(Wt + (size_t)j * D + ch); w0[j] = w.x; w1[j] = w.y; }
        const f32x2 bb = *(const f32x2*)(Bi + ch);
        float r0[CONVK], r1[CONVK];
        asm volatile("s_waitcnt vmcnt(0)" ::: "memory");
#pragma unroll
        for (int q = 0; q < CONVK - 1; ++q) {
            const int p = pbase - CONVP + q; float x0 = 0.f, x1 = 0.f;
            if (p >= 0 && p < L) { const unsigned w = *(const LAS unsigned*)(T + q * 256 + 4 * C.lane); x0 = bf_lo(w); x1 = bf_hi(w); }
            r0[q % CONVK] = x0; r1[q % CONVK] = x1;
        }
#pragma unroll
        for (int o = 0; o < 32; ++o) {
            { const int q = o + CONVK - 1; const int p = pbase - CONVP + q; float x0 = 0.f, x1 = 0.f;
              if (p >= 0 && p < L) { const unsigned w = *(const LAS unsigned*)(T + q * 256 + 4 * C.lane); x0 = bf_lo(w); x1 = bf_hi(w); }
              r0[q % CONVK] = x0; r1[q % CONVK] = x1; }
            float s0 = bb.x, s1 = bb.y;
#pragma unroll
            for (int j = 0; j < CONVK; ++j) { s0 += w0[j] * r0[(o + j) % CONVK]; s1 += w1[j] * r1[(o + j) % CONVK]; }
            *(unsigned*)(CV + (size_t)(tb + (pbase + o) * ps) * D + ch) = pk2(s0, s1);
        }
        asm volatile("s_waitcnt lgkmcnt(0)" ::: "memory");
    }
}

__device__ __forceinline__ void ph_ln_silu(const Ctx& C) {
    const bf16* CV = WSP(const bf16, WS_CV); bf16* A2 = WSP(bf16, WS_A2);
    const float* G = C.in[I_LNG]; const float* Bv = C.in[I_LNB];
    const int gw = C.vcu * NWAVES + C.wave, NGW = C.G * NWAVES;
    LAS float* VG = (LAS float*)C.lds; LAS float* VB = VG + D;
    for (int i = C.tid; i < D / 4; i += NTHREADS) { *(LAS f32x4*)(VG + 4 * i) = *(const f32x4*)(G + 4 * i); *(LAS f32x4*)(VB + 4 * i) = *(const f32x4*)(Bv + 4 * i); }
    __syncthreads();
    if (gw >= TT) return;
    u32x4 wc[4], wn[4];
#pragma unroll
    for (int j = 0; j < 4; ++j) wc[j] = __builtin_nontemporal_load((const u32x4*)(CV + (size_t)gw * D + 8 * (64 * j + C.lane)));
    for (int row = gw; row < TT; row += NGW) {
        if (row + NGW < TT) {
#pragma unroll
            for (int j = 0; j < 4; ++j) wn[j] = __builtin_nontemporal_load((const u32x4*)(CV + (size_t)(row + NGW) * D + 8 * (64 * j + C.lane)));
        }
        float x[32]; float s = 0.f;
#pragma unroll
        for (int j = 0; j < 4; ++j) {
            const u32x4 w = wc[j];
            x[8 * j + 0] = bf_lo(w.x); x[8 * j + 1] = bf_hi(w.x); x[8 * j + 2] = bf_lo(w.y); x[8 * j + 3] = bf_hi(w.y);
            x[8 * j + 4] = bf_lo(w.z); x[8 * j + 5] = bf_hi(w.z); x[8 * j + 6] = bf_lo(w.w); x[8 * j + 7] = bf_hi(w.w);
        }
#pragma unroll
        for (int i = 0; i < 32; ++i) s += x[i];
        const float mean = wave_sum(s) * (1.0f / D); float q = 0.f;
#pragma unroll
        for (int i = 0; i < 32; ++i) { x[i] -= mean; q += x[i] * x[i]; }
        const float rstd = rsqrtf(wave_sum(q) * (1.0f / D) + EPS);
#pragma unroll
        for (int j = 0; j < 4; ++j) {
            const int k = 8 * (64 * j + C.lane);
            const f32x4 g0 = *(LAS const f32x4*)(VG + k), g1 = *(LAS const f32x4*)(VG + k + 4), b0 = *(LAS const f32x4*)(VB + k), b1 = *(LAS const f32x4*)(VB + k + 4);
            float y[8];
            y[0] = x[8 * j + 0] * rstd * g0.x + b0.x; y[1] = x[8 * j + 1] * rstd * g0.y + b0.y; y[2] = x[8 * j + 2] * rstd * g0.z + b0.z; y[3] = x[8 * j + 3] * rstd * g0.w + b0.w;
            y[4] = x[8 * j + 4] * rstd * g1.x + b1.x; y[5] = x[8 * j + 5] * rstd * g1.y + b1.y; y[6] = x[8 * j + 6] * rstd * g1.z + b1.z; y[7] = x[8 * j + 7] * rstd * g1.w + b1.w;
            if (F8_PW2) { u32x2 w; w.x = pk4_fp8(siluf_(y[0]), siluf_(y[1]), siluf_(y[2]), siluf_(y[3])); w.y = pk4_fp8(siluf_(y[4]), siluf_(y[5]), siluf_(y[6]), siluf_(y[7]));
                *(u32x2*)((unsigned char*)A2 + (size_t)row * D + k) = w; }
            else { u32x4 w; w.x = pk2(siluf_(y[0]), siluf_(y[1])); w.y = pk2(siluf_(y[2]), siluf_(y[3])); w.z = pk2(siluf_(y[4]), siluf_(y[5])); w.w = pk2(siluf_(y[6]), siluf_(y[7]));
                *(u32x4*)(A2 + (size_t)row * D + k) = w; }
        }
#pragma unroll
        for (int j = 0; j < 4; ++j) wc[j] = wn[j];
    }
}

__device__ __forceinline__ void ph_fold_router(const Ctx& C) {
    float* RWF = WSP(float, WS_RWF); float* RC = WSP(float, WS_RC);
    const int gt = C.vcu * NTHREADS + C.tid, NGT = C.G * NTHREADS;
    for (int i = gt; i < 6 * D * NE / 4; i += NGT) {
        const int ls = i / (D * NE / 4), r = i % (D * NE / 4), k = r / (NE / 4), l = ls / 3, s = ls % 3;
        const float al = C.in[I_N2G][l * D + k] * (1.0f + modp(C, l, s, 4)[k]);
        const f32x4 w = *(const f32x4*)(C.in[I_RW] + (size_t)l * D * NE + (size_t)r * 4);
        *(f32x4*)(RWF + (size_t)ls * D * NE + (size_t)r * 4) = w * al;
    }
    if (C.vcu < 6) {
        const int l = C.vcu / 3, s = C.vcu % 3, e = C.tid & 31, kg = C.tid >> 5;
        LAS float* red = (LAS float*)C.lds;
        const float* sh = modp(C, l, s, 3); const float* rw = C.in[I_RW] + (size_t)l * D * NE;
        float a = 0.f, a2 = 0.f, a3 = 0.f, a4 = 0.f;
#pragma unroll 8
        for (int k = kg * 128; k < kg * 128 + 128; k += 4) { a += sh[k] * rw[(size_t)k * NE + e]; a2 += sh[k + 1] * rw[(size_t)(k + 1) * NE + e]; a3 += sh[k + 2] * rw[(size_t)(k + 2) * NE + e]; a4 += sh[k + 3] * rw[(size_t)(k + 3) * NE + e]; }
        a = (a + a2) + (a3 + a4);
        red[C.tid] = a;
        __syncthreads();
        if (C.tid < 32) { float v = C.in[I_RB][l * NE + e];
#pragma unroll
            for (int g = 0; g < 16; ++g) v += red[g * 32 + e];
            RC[(l * 3 + s) * NE + e] = v; }
        __syncthreads();
    }
}

constexpr int RT_LD = D + 4;
template <bool BASE16> __device__ __forceinline__ void ph_router(const Ctx& C, int layer, const void* Hlat_, const void* Hctx_, int nrows, bf16* Hout, bf16* FN, int lset) {
    const float* Hlat = (const float*)Hlat_; const float* Hctx = (const float*)Hctx_; const bf16* Hlat16 = (const bf16*)Hlat_;
    const bf16* DL = WSP(const bf16, WS_DELTA);
    const float* gain = C.in[I_N2G] + layer * D;
    int* list = WSP(int, WS_LIST) + (size_t)lset * NE * LCAP; float* plist = WSP(float, WS_PLIST) + (size_t)lset * NE * LCAP;
    unsigned* cnt = C.ctl + CW_CNT + lset * 64;
    LAS float* AR = (LAS float*)C.lds;
    LAS float* RED = AR + 16 * RT_LD;
    LAS float* RS = RED + 8 * 16 * 32;
    const int li = C.lane & 15, kq = C.lane >> 4;
    f32x4 xr[2][8]; u32x2 dr[2][8];
    auto load_task = [&](int tk) {
        const int r0 = tk * 16; const float* Hq = r0 < TL ? Hlat : Hctx - (size_t)TL * D;
#pragma unroll
        for (int rr = 0; rr < 2; ++rr) { const int row = r0 + 2 * C.wave + rr;
            if (BASE16) {
#pragma unroll
                for (int j = 0; j < 8; ++j) { const u32x2 w = *(const u32x2*)(Hlat16 + (size_t)row * D + 256 * j + 4 * C.lane); xr[rr][j] = (f32x4){bf_lo(w.x), bf_hi(w.x), bf_lo(w.y), bf_hi(w.y)}; }
            } else load_row_f32(Hq + (size_t)row * D, C.lane, xr[rr]);
#pragma unroll
            for (int j = 0; j < 8; ++j) dr[rr][j] = *(const u32x2*)(DL + (size_t)row * D + 256 * j + 4 * C.lane); }
    };
    if (C.vcu < nrows / 16) load_task(C.vcu);
    for (int task = C.vcu; task < nrows / 16; task += C.G) {
        const int row0 = task * 16, s = seg_of_row(row0);
#pragma unroll
        for (int rr = 0; rr < 2; ++rr) {
            const int rl = 2 * C.wave + rr, row = row0 + rl;
            float ss = 0.f;
#pragma unroll
            for (int j = 0; j < 8; ++j) {
                const int k = 256 * j + 4 * C.lane; const u32x2 dw = dr[rr][j]; f32x4 x = xr[rr][j];
                x.x += bf_lo(dw.x); x.y += bf_hi(dw.x); x.z += bf_lo(dw.y); x.w += bf_hi(dw.y);
                ss += (x.x * x.x + x.y * x.y) + (x.z * x.z + x.w * x.w);
                { u32x2 hw; hw.x = pk2(x.x, x.y); hw.y = pk2(x.z, x.w); *(u32x2*)(Hout + (size_t)row * D + k) = hw; }
                *(LAS f32x4*)(AR + rl * RT_LD + k) = x;
            }
            const float rstd = rsqrtf(wave_sum(ss) * (1.0f / D) + EPS);
            if (C.lane == 0) RS[rl] = rstd;
        }
        if (task + C.G < nrows / 16) load_task(task + C.G);
        __syncthreads();
        {
            const float* W = WSP(const float, WS_RWF) + (size_t)(layer * 3 + s) * D * NE + (size_t)(256 * C.wave + 4 * kq) * NE + li;
            LAS const float* ap = AR + li * RT_LD + 256 * C.wave + 4 * kq;
            f32x4 acc0 = {0.f, 0.f, 0.f, 0.f}, acc1 = acc0;
#pragma unroll 4
            for (int sp = 0; sp < 16; ++sp) {
                const f32x4 a = *(const LAS f32x4*)(ap + 16 * sp);
                float b0[4], b1[4];
#pragma unroll
                for (int j = 0; j < 4; ++j) { b0[j] = W[(size_t)(16 * sp + j) * NE]; b1[j] = W[(size_t)(16 * sp + j) * NE + 16]; }
#pragma unroll
                for (int j = 0; j < 4; ++j) {
                    acc0 = __builtin_amdgcn_mfma_f32_16x16x4f32(a[j], b0[j], acc0, 0, 0, 0);
                    acc1 = __builtin_amdgcn_mfma_f32_16x16x4f32(a[j], b1[j], acc1, 0, 0, 0);
                }
            }
#pragma unroll
            for (int r = 0; r < 4; ++r) { RED[(C.wave * 16 + 4 * kq + r) * 32 + li] = acc0[r]; RED[(C.wave * 16 + 4 * kq + r) * 32 + 16 + li] = acc1[r]; }
        }
        __syncthreads();
        if (C.wave == 0) {
            const float* RCv = WSP(const float, WS_RC) + (layer * 3 + s) * NE;
            const float c0 = RCv[li], c1 = RCv[16 + li];
            float k0[4], k1[4];
#pragma unroll
            for (int r = 0; r < 4; ++r) {
                float a0 = 0.f, a1 = 0.f;
#pragma unroll
                for (int w = 0; w < 8; ++w) { a0 += RED[(w * 16 + 4 * kq + r) * 32 + li]; a1 += RED[(w * 16 + 4 * kq + r) * 32 + 16 + li]; }
                const float rs = RS[4 * kq + r];
                k0[r] = __uint_as_float((__float_as_uint(a0 * rs + c0) & ~31u) | (unsigned)(31 - li));
                k1[r] = __uint_as_float((__float_as_uint(a1 * rs + c1) & ~31u) | (unsigned)(15 - li));
            }
            float tv[4][TOPK];
#pragma unroll
            for (int k = 0; k < TOPK; ++k)
#pragma unroll
                for (int r = 0; r < 4; ++r) {
                    float x = fmaxf(k0[r], k1[r]);
                    x = fmaxf(x, __uint_as_float((unsigned)__builtin_amdgcn_update_dpp(0, (int)__float_as_uint(x), 0xB1, 0xF, 0xF, true)));
                    x = fmaxf(x, __uint_as_float((unsigned)__builtin_amdgcn_update_dpp(0, (int)__float_as_uint(x), 0x4E, 0xF, 0xF, true)));
                    x = fmaxf(x, __uint_as_float((unsigned)__builtin_amdgcn_update_dpp(0, (int)__float_as_uint(x), 0x141, 0xF, 0xF, true)));
                    x = fmaxf(x, __uint_as_float((unsigned)__builtin_amdgcn_update_dpp(0, (int)__float_as_uint(x), 0x140, 0xF, 0xF, true)));
                    tv[r][k] = x;
                    if (__float_as_uint(k0[r]) == __float_as_uint(x)) k0[r] = -3.0e38f;
                    if (__float_as_uint(k1[r]) == __float_as_uint(x)) k1[r] = -3.0e38f;
                }
            const int r = li >> 2, k = li & 3; float sv = 0.f, mv = 0.f, den = 0.f;
#pragma unroll
            for (int rr = 0; rr < 4; ++rr) if (rr == r) {
                mv = tv[rr][0];
#pragma unroll
                for (int kk = 0; kk < TOPK; ++kk) { den += __expf(tv[rr][kk] - tv[rr][0]); if (kk == k) sv = tv[rr][kk]; }
            }
            const int se = 31 - (int)(__float_as_uint(sv) & 31u);
            const float p = __expf(sv - mv) / den;
            const int row = row0 + 4 * kq + r;
            const unsigned long long ltm = (1ull << C.lane) - 1ull; int myrank = 0, mycount = 0;
#pragma unroll 4
            for (int e = 0; e < NE; ++e) { const unsigned long long m = __ballot(se == e); if (se == e) myrank = __popcll(m & ltm); if (C.lane == e) mycount = __popcll(m); }
            unsigned base = 0u; if (C.lane < NE && mycount > 0) base = atomicAdd(cnt + C.lane, (unsigned)mycount);
            const unsigned pos = (unsigned)__shfl((int)base, se) + (unsigned)myrank;
            list[(size_t)se * LCAP + pos] = row * 4 + k;
            plist[(size_t)se * LCAP + pos] = p;
        }
        const float* scv = modp(C, layer, s, 4); const float* shv = modp(C, layer, s, 3);
#pragma unroll
        for (int rr = 0; rr < 2; ++rr) {
            const int rl = 2 * C.wave + rr, row = row0 + rl; const float rs = RS[rl];
            unsigned char* o = (unsigned char*)FN + (size_t)row * D;
#pragma unroll
            for (int j = 0; j < 8; ++j) {
                const int k = 256 * j + 4 * C.lane;
                const f32x4 x = *(const LAS f32x4*)(AR + rl * RT_LD + k), g = *(const f32x4*)(gain + k), s1 = *(const f32x4*)(scv + k), s0 = *(const f32x4*)(shv + k);
                const f32x4 y = x * rs * g * (1.0f + s1) + s0;
                *(unsigned*)(o + k) = pk4_fp8(y.x, y.y, y.z, y.w);
            }
        }
        __syncthreads();
    }
}

__device__ __forceinline__ void ph_combine(const Ctx& C, int layer, const bf16* Hin, const bf16* Yb, int nrows, bf16* Hout, bf16* XN, float* fout) {
    const unsigned char* Y = (const unsigned char*)Yb;
    const int gw = C.vcu * NWAVES + C.wave, NGW = C.G * NWAVES;
    LAS float* VG = (LAS float*)C.lds; LAS float* VA = VG + 3 * D; LAS float* VB = VA + 3 * D;
    for (int i = C.tid; i < 3 * (D / 4); i += NTHREADS) {
        const int sg = i / (D / 4), k = (i - sg * (D / 4)) * 4;
        *(LAS f32x4*)(VG + sg * D + k) = *(const f32x4*)(modp(C, layer, sg, 5) + k);
        if (XN) { *(LAS f32x4*)(VA + sg * D + k) = *(const f32x4*)(C.in[I_N1G] + (layer + 1) * D + k) * (1.0f + *(const f32x4*)(modp(C, layer + 1, sg, 1) + k)); *(LAS f32x4*)(VB + sg * D + k) = *(const f32x4*)(modp(C, layer + 1, sg, 0) + k); }
        else if (sg == 0) *(LAS f32x4*)(VA + k) = *(const f32x4*)(C.in[I_FG] + k);
    }
    __syncthreads();
    if (gw >= nrows) return;
    f32x4 x[4][2], xn[4][2]; u32x2 yw[4][4], yn[4][4];
    auto load_row = [&](int row, f32x4 (&xx)[4][2], u32x2 (&yy)[4][4]) {
#pragma unroll
        for (int j = 0; j < 4; ++j) {
            const int k = 512 * j + 8 * C.lane;
            { const u32x4 hw = __builtin_nontemporal_load((const u32x4*)(Hin + (size_t)row * D + k)); xx[j][0] = (f32x4){bf_lo(hw.x), bf_hi(hw.x), bf_lo(hw.y), bf_hi(hw.y)}; xx[j][1] = (f32x4){bf_lo(hw.z), bf_hi(hw.z), bf_lo(hw.w), bf_hi(hw.w)}; }
#pragma unroll
            for (int q = 0; q < 4; ++q) yy[j][q] = __builtin_nontemporal_load((const u32x2*)(Y + ((size_t)row * 4 + q) * D + k));
        }
    };
    load_row(gw, x, yw);
    for (int row = gw; row < nrows; row += NGW) {
        const int s = seg_of_row(row); LAS const float* g2 = VG + s * D;
        if (row + NGW < nrows) load_row(row + NGW, xn, yn);
        float ss = 0.f;
#pragma unroll
        for (int j = 0; j < 4; ++j) {
            const int k = 512 * j + 8 * C.lane; f32x4 s0 = {0.f, 0.f, 0.f, 0.f}, s1 = s0;
#pragma unroll
            for (int q = 0; q < 4; ++q) {
                const f32x2 a = __builtin_amdgcn_cvt_pk_f32_fp8((int)yw[j][q].x, false), b = __builtin_amdgcn_cvt_pk_f32_fp8((int)yw[j][q].x, true);
                const f32x2 c = __builtin_amdgcn_cvt_pk_f32_fp8((int)yw[j][q].y, false), d = __builtin_amdgcn_cvt_pk_f32_fp8((int)yw[j][q].y, true);
                s0.x += a.x; s0.y += a.y; s0.z += b.x; s0.w += b.y; s1.x += c.x; s1.y += c.y; s1.z += d.x; s1.w += d.y;
            }
            x[j][0] += *(LAS const f32x4*)(g2 + k) * s0; x[j][1] += *(LAS const f32x4*)(g2 + k + 4) * s1;
#pragma unroll
            for (int h = 0; h < 2; ++h) ss += (x[j][h].x * x[j][h].x + x[j][h].y * x[j][h].y) + (x[j][h].z * x[j][h].z + x[j][h].w * x[j][h].w);
        }
        const float rstd = rsqrtf(wave_sum(ss) * (1.0f / D) + EPS);
        if (XN) {
            LAS const float* va = VA + s * D; LAS const float* vb = VB + s * D;
#pragma unroll
            for (int j = 0; j < 4; ++j) {
                const int k = 512 * j + 8 * C.lane;
                { u32x4 hw; hw.x = pk2(x[j][0].x, x[j][0].y); hw.y = pk2(x[j][0].z, x[j][0].w); hw.z = pk2(x[j][1].x, x[j][1].y); hw.w = pk2(x[j][1].z, x[j][1].w); *(u32x4*)(Hout + (size_t)row * D + k) = hw; }
                f32x4 y[2];
#pragma unroll
                for (int h = 0; h < 2; ++h) y[h] = x[j][h] * rstd * *(LAS const f32x4*)(va + k + 4 * h) + *(LAS const f32x4*)(vb + k + 4 * h);
                if (F8_WXY) { u32x2 w; w.x = pk4_fp8(y[0].x, y[0].y, y[0].z, y[0].w); w.y = pk4_fp8(y[1].x, y[1].y, y[1].z, y[1].w); *(u32x2*)((unsigned char*)XN + (size_t)row * D + k) = w; }
                else { u32x4 w; w.x = pk2(y[0].x, y[0].y); w.y = pk2(y[0].z, y[0].w); w.z = pk2(y[1].x, y[1].y); w.w = pk2(y[1].z, y[1].w); *(u32x4*)(XN + (size_t)row * D + k) = w; }
            }
        } else {
#pragma unroll
            for (int j = 0; j < 4; ++j) {
                const int k = 512 * j + 8 * C.lane;
                *(f32x4*)(fout + (size_t)row * D + k) = x[j][0] * rstd * *(LAS const f32x4*)(VA + k); *(f32x4*)(fout + (size_t)row * D + k + 4) = x[j][1] * rstd * *(LAS const f32x4*)(VA + k + 4);
            }
        }
#pragma unroll
        for (int j = 0; j < 4; ++j) { x[j][0] = xn[j][0]; x[j][1] = xn[j][1];
#pragma unroll
            for (int q = 0; q < 4; ++q) yw[j][q] = yn[j][q]; }
    }
}

typedef float f32x16 __attribute__((ext_vector_type(16)));
constexpr int LRU_ALD = 272;
template <int DIR> __device__ __forceinline__ void lru_scan(f32x16 (&acc)[2][2], int hh, float& ch, float& cp) {
    float As[2][4], Us[2][4];
#pragma unroll
    for (int mt = 0; mt < 2; ++mt)
#pragma unroll
        for (int q = 0; q < 4; ++q) {
            float h = 0.f, p = 1.f;
#pragma unroll
            for (int ee = 0; ee < 4; ++ee) { const int e = DIR ? 3 - ee : ee; const float a = acc[mt][0][4 * q + e], u = acc[mt][1][4 * q + e]; h = a * h + u; p = p * a; acc[mt][1][4 * q + e] = h; acc[mt][0][4 * q + e] = p; }
            As[mt][q] = p; Us[mt][q] = h;
        }
    ch = 0.f; cp = 1.f;
#pragma unroll
    for (int ii = 0; ii < 8; ++ii) {
        const int i = DIR ? 7 - ii : ii, mt = i >> 2, q = i & 3;
        const float Ao = __shfl_xor(As[mt][q], 32), Uo = __shfl_xor(Us[mt][q], 32);
        const float A0 = hh ? Ao : As[mt][q], U0 = hh ? Uo : Us[mt][q], A1 = hh ? As[mt][q] : Ao, U1 = hh ? Us[mt][q] : Uo;
        const float Af = DIR ? A1 : A0, Uf = DIR ? U1 : U0, Al = DIR ? A0 : A1, Ul = DIR ? U0 : U1;
        const float ch1 = Af * ch + Uf, cp1 = Af * cp;
        const bool mine_first = DIR ? (hh == 1) : (hh == 0);
        const float myh = mine_first ? ch : ch1, myp = mine_first ? cp : cp1;
#pragma unroll
        for (int e = 0; e < 4; ++e) { const float pl = acc[mt][0][4 * q + e]; acc[mt][1][4 * q + e] += pl * myh; acc[mt][0][4 * q + e] = pl * myp; }
        ch = Al * ch1 + Ul; cp = Al * cp1;
    }
}
__device__ __forceinline__ void ph_lru(const Ctx& C) {
    const bf16* XB = WSP(const bf16, WS_XB); bf16* HL = WSP(bf16, WS_HL); bf16* PP = WSP(bf16, WS_PP); float* SA = WSP(float, WS_SA); float* SU = WSP(float, WS_SU);
    const float* Wc = C.in[I_LCW]; const float* Bc = C.in[I_LCB];
    LAS unsigned char* Bimg = C.lds;
    LAS unsigned char* Aimg = C.lds + 131072;
    LAS float* CW = (LAS float*)(C.lds + 131072 + 64 * LRU_ALD);
    const int d = C.wave >> 2, g = C.wave & 3, col = C.lane & 31, hh = C.lane >> 5;
    int hprev = -1; float ba = 0.f, bi = 0.f, sp8 = 0.f;
    u32x4 xr[4][2];
    auto load_rows = [&](int uu) {
        const int hq = uu & 15, cq = uu >> 4, r0 = cq * 64, t = C.tid >> 3, cg = C.tid & 7, row = r0 + t, chb = hq * HBLK + 16 * cg;
        int s0, s1; if (r0 < TL) { s0 = r0 & ~(SEQ - 1); s1 = s0 + SEQ; } else { s0 = TL + ((r0 - TL) & ~(CTXL - 1)); s1 = s0 + CTXL; }
#pragma unroll
        for (int q = 0; q < 4; ++q) { const int rr = row + q - 1; const int rc = (rr >= s0 && rr < s1) ? rr : row;
            xr[q][0] = *(const u32x4*)(XB + (size_t)rc * D + chb); xr[q][1] = *(const u32x4*)(XB + (size_t)rc * D + chb + 8); }
    };
    if (C.vcu < 136 * NHEAD) load_rows(C.vcu);
    for (int u = C.vcu; u < 136 * NHEAD; u += C.G) {
        const int h = u & 15, ci = u >> 4, row0 = ci * 64; const bool lat = ci < 128;
        if (h != hprev) {
            hprev = h;
            const float* Wa = C.in[I_WA] + (size_t)(d * NHEAD + h) * HBLK * HBLK + 32 * g + col + 8 * hh * HBLK; const float* Wi = C.in[I_WI] + (size_t)(d * NHEAD + h) * HBLK * HBLK + 32 * g + col + 8 * hh * HBLK;
#pragma unroll
            for (int ks = 0; ks < 8; ++ks) {
                float fa[8], fi[8];
                asm volatile("" : "+v"(Wa), "+v"(Wi));
#pragma unroll
                for (int j = 0; j < 8; ++j) { fa[j] = Wa[j * HBLK]; fi[j] = Wi[j * HBLK]; }
                Wa += 16 * HBLK; Wi += 16 * HBLK;
                u32x4 wa, wi; wa.x = pk2(fa[0], fa[1]); wa.y = pk2(fa[2], fa[3]); wa.z = pk2(fa[4], fa[5]); wa.w = pk2(fa[6], fa[7]);
                wi.x = pk2(fi[0], fi[1]); wi.y = pk2(fi[2], fi[3]); wi.z = pk2(fi[4], fi[5]); wi.w = pk2(fi[6], fi[7]);
                *(LAS u32x4*)(Bimg + ((C.wave * 2 + 0) * 8 + ks) * 1024 + C.lane * 16) = wa; *(LAS u32x4*)(Bimg + ((C.wave * 2 + 1) * 8 + ks) * 1024 + C.lane * 16) = wi;
            }
            const int cch = h * HBLK + 32 * g + col;
            ba = C.in[I_BA][d * D + cch]; bi = C.in[I_BI][d * D + cch]; sp8 = -8.0f * 1.4426950408889634f * log1pf(expf(-C.in[I_LAM][d * D + cch]));
            for (int i = C.tid; i < 5 * HBLK; i += NTHREADS) CW[i] = i < 4 * HBLK ? Wc[(i >> 7) * D + h * HBLK + (i & 127)] : Bc[h * HBLK + (i & 127)];
            __syncthreads();
        }
        {
            const int t = C.tid >> 3, cg = C.tid & 7, row = row0 + t, chb = h * HBLK + 16 * cg;
            int s0, s1; if (row0 < TL) { s0 = row0 & ~(SEQ - 1); s1 = s0 + SEQ; } else { s0 = TL + ((row0 - TL) & ~(CTXL - 1)); s1 = s0 + CTXL; }
            float o[16];
#pragma unroll
            for (int i = 0; i < 4; ++i) { const f32x4 b = *(const LAS f32x4*)(CW + 4 * HBLK + 16 * cg + 4 * i); o[4 * i] = b.x; o[4 * i + 1] = b.y; o[4 * i + 2] = b.z; o[4 * i + 3] = b.w; }
#pragma unroll
            for (int q = 0; q < 4; ++q) {
                const int rr = row + q - 1; const bool ok = rr >= s0 && rr < s1;
                const u32x4 x0 = xr[q][0], x1 = xr[q][1];
                const unsigned xw[8] = {x0.x, x0.y, x0.z, x0.w, x1.x, x1.y, x1.z, x1.w};
#pragma unroll
                for (int i = 0; i < 4; ++i) { f32x4 w = *(const LAS f32x4*)(CW + q * HBLK + 16 * cg + 4 * i); if (!ok) w = (f32x4){0.f, 0.f, 0.f, 0.f};
                    o[4 * i] += w.x * bf_lo(xw[2 * i]); o[4 * i + 1] += w.y * bf_hi(xw[2 * i]); o[4 * i + 2] += w.z * bf_lo(xw[2 * i + 1]); o[4 * i + 3] += w.w * bf_hi(xw[2 * i + 1]); }
            }
            u32x4 w0, w1; w0.x = pk2(o[0], o[1]); w0.y = pk2(o[2], o[3]); w0.z = pk2(o[4], o[5]); w0.w = pk2(o[6], o[7]);
            w1.x = pk2(o[8], o[9]); w1.y = pk2(o[10], o[11]); w1.z = pk2(o[12], o[13]); w1.w = pk2(o[14], o[15]);
            *(LAS u32x4*)(Aimg + t * LRU_ALD + cg * 32) = w0; *(LAS u32x4*)(Aimg + t * LRU_ALD + cg * 32 + 16) = w1;
        }
        __syncthreads();
        if (u + C.G < 136 * NHEAD) load_rows(u + C.G);
        f32x16 acc[2][2];
#pragma unroll
        for (int mt = 0; mt < 2; ++mt)
#pragma unroll
            for (int ri = 0; ri < 2; ++ri)
#pragma unroll
                for (int r = 0; r < 16; ++r) acc[mt][ri][r] = 0.f;
#pragma unroll
        for (int ks = 0; ks < 8; ++ks)
#pragma unroll
            for (int mt = 0; mt < 2; ++mt) {
                const bf16x8 af = *(const LAS bf16x8*)(Aimg + (32 * mt + col) * LRU_ALD + (16 * ks + 8 * hh) * 2);
                const bf16x8 b0 = *(const LAS bf16x8*)(Bimg + ((C.wave * 2 + 0) * 8 + ks) * 1024 + C.lane * 16), b1 = *(const LAS bf16x8*)(Bimg + ((C.wave * 2 + 1) * 8 + ks) * 1024 + C.lane * 16);
                acc[mt][0] = __builtin_amdgcn_mfma_f32_32x32x16_bf16(af, b0, acc[mt][0], 0, 0, 0);
                acc[mt][1] = __builtin_amdgcn_mfma_f32_32x32x16_bf16(af, b1, acc[mt][1], 0, 0, 0);
            }
#pragma unroll
        for (int mt = 0; mt < 2; ++mt)
#pragma unroll
            for (int r = 0; r < 16; ++r) {
                const int tk = 32 * mt + (r & 3) + 8 * (r >> 2) + 4 * hh;
                const float xv = bf_lo((unsigned)*(const LAS unsigned short*)(Aimg + tk * LRU_ALD + (32 * g + col) * 2));
                const float rg = __builtin_amdgcn_rcpf(1.0f + __builtin_amdgcn_exp2f(-1.4426950408889634f * (acc[mt][0][r] + ba))), ig = __builtin_amdgcn_rcpf(1.0f + __builtin_amdgcn_exp2f(-1.4426950408889634f * (acc[mt][1][r] + bi)));
                const float a = __builtin_amdgcn_exp2f(sp8 * rg);
                acc[mt][0][r] = a; acc[mt][1][r] = xv * ig * __builtin_amdgcn_sqrtf((1.0f - a) * (1.0f + a));
            }
        float ch, cp;
        if (d == 0) lru_scan<0>(acc, hh, ch, cp); else lru_scan<1>(acc, hh, ch, cp);
        const int cch = h * HBLK + 32 * g + col;
        if (lat) {
            const bool odd = (col & 1) != 0;
            size_t o = ((size_t)d * TL + row0 + 4 * hh + (odd ? 1 : 0)) * D + (cch & ~1);
#pragma unroll
            for (int mt = 0; mt < 2; ++mt)
#pragma unroll
                for (int q = 0; q < 4; ++q) {
#pragma unroll
                    for (int ep = 0; ep < 2; ++ep) {
                        asm volatile("" : "+v"(o));
                        const float h0 = acc[mt][1][4 * q + 2 * ep], h1 = acc[mt][1][4 * q + 2 * ep + 1], p0 = acc[mt][0][4 * q + 2 * ep], p1 = acc[mt][0][4 * q + 2 * ep + 1];
                        const float hx = __uint_as_float((unsigned)__builtin_amdgcn_update_dpp(0, (int)__float_as_uint(odd ? h0 : h1), 0xB1, 0xF, 0xF, true));
                        const float px = __uint_as_float((unsigned)__builtin_amdgcn_update_dpp(0, (int)__float_as_uint(odd ? p0 : p1), 0xB1, 0xF, 0xF, true));
                        *(unsigned*)(HL + o) = odd ? pk2(hx, h1) : pk2(h0, hx);
                        *(unsigned*)(PP + o) = odd ? pk2(px, p1) : pk2(p0, px);
                        o += 2 * D;
                    }
                    o += 4 * D;
                }
        }
        if (hh == 0) { SA[((size_t)ci * 2 + d) * D + cch] = cp; SU[((size_t)ci * 2 + d) * D + cch] = ch; }
        __syncthreads();
    }
}

__device__ __forceinline__ void ph_fixup(const Ctx& C) {
    const bf16* HL = WSP(const bf16, WS_HL); const bf16* PP = WSP(const bf16, WS_PP); const float* SA = WSP(const float, WS_SA); const float* SU = WSP(const float, WS_SU);
    const bf16* YL = WSP(const bf16, WS_YL); bf16* Z = WSP(bf16, WS_Z);
    for (int u = C.vcu; u < 128 * 2; u += C.G) {
        const int th = u & 1, ci = u >> 1, b = ci >> 6, j = ci & 63; const int ch = 4 * C.tid;
        f32x4 cf = {0.f, 0.f, 0.f, 0.f}, cb = cf;
#pragma unroll
        for (int q = 0; q < 4; ++q) { const size_t o = ((size_t)(128 + 4 * b + q) * 2 + 0) * D + ch; cf = *(const f32x4*)(SA + o) * cf + *(const f32x4*)(SU + o); }
        for (int j0 = 0; j0 < j; j0 += 8) {
            f32x4 ta[8], tu[8];
#pragma unroll
            for (int i = 0; i < 8; ++i) { const int jj = (j0 + i < j) ? j0 + i : j0; const size_t o = ((size_t)(64 * b + jj) * 2 + 0) * D + ch; ta[i] = *(const f32x4*)(SA + o); tu[i] = *(const f32x4*)(SU + o); }
#pragma unroll
            for (int i = 0; i < 8; ++i) if (j0 + i < j) cf = ta[i] * cf + tu[i];
        }
#pragma unroll
        for (int q = 3; q >= 0; --q) { const size_t o = ((size_t)(128 + 4 * b + q) * 2 + 1) * D + ch; cb = *(const f32x4*)(SA + o) * cb + *(const f32x4*)(SU + o); }
        for (int j0 = 63; j0 > j; j0 -= 8) {
            f32x4 ta[8], tu[8];
#pragma unroll
            for (int i = 0; i < 8; ++i) { const int jj = (j0 - i > j) ? j0 - i : j0; const size_t o = ((size_t)(64 * b + jj) * 2 + 1) * D + ch; ta[i] = *(const f32x4*)(SA + o); tu[i] = *(const f32x4*)(SU + o); }
#pragma unroll
            for (int i = 0; i < 8; ++i) if (j0 - i > j) cb = ta[i] * cb + tu[i];
        }
        const size_t o0 = (size_t)(ci * 64 + th * 32) * D + ch;
        u32x2 ra[4][5], rb[4][5];
        auto load4 = [&](int q0, u32x2 (&r)[4][5]) {
#pragma unroll
            for (int i = 0; i < 4; ++i) { const size_t o = o0 + (size_t)(q0 + i) * D;
                r[i][0] = __builtin_nontemporal_load((const u32x2*)(HL + o)); r[i][1] = __builtin_nontemporal_load((const u32x2*)(PP + o));
                r[i][2] = __builtin_nontemporal_load((const u32x2*)(HL + (size_t)TL * D + o)); r[i][3] = __builtin_nontemporal_load((const u32x2*)(PP + (size_t)TL * D + o));
                r[i][4] = __builtin_nontemporal_load((const u32x2*)(YL + o)); }
        };
        auto emit4 = [&](int q0, const u32x2 (&rr)[4][5]) {
#pragma unroll
            for (int i = 0; i < 4; ++i) { const size_t o = o0 + (size_t)(q0 + i) * D;
                const u32x2 hf = rr[i][0], pf = rr[i][1], hb = rr[i][2], pb = rr[i][3], yv = rr[i][4];
                float r[4];
                r[0] = (bf_lo(hf.x) + bf_lo(pf.x) * cf.x) + (bf_lo(hb.x) + bf_lo(pb.x) * cb.x);
                r[1] = (bf_hi(hf.x) + bf_hi(pf.x) * cf.y) + (bf_hi(hb.x) + bf_hi(pb.x) * cb.y);
                r[2] = (bf_lo(hf.y) + bf_lo(pf.y) * cf.z) + (bf_lo(hb.y) + bf_lo(pb.y) * cb.z);
                r[3] = (bf_hi(hf.y) + bf_hi(pf.y) * cf.w) + (bf_hi(hb.y) + bf_hi(pb.y) * cb.w);
                if (F8_WO) *(unsigned*)((unsigned char*)Z + o) = pk4_fp8(bf_lo(yv.x) * r[0], bf_hi(yv.x) * r[1], bf_lo(yv.y) * r[2], bf_hi(yv.y) * r[3]);
                else { u32x2 w; w.x = pk2(bf_lo(yv.x) * r[0], bf_hi(yv.x) * r[1]); w.y = pk2(bf_lo(yv.y) * r[2], bf_hi(yv.y) * r[3]); *(u32x2*)(Z + o) = w; } }
        };
        const int rot = 4 * (ci & 7);
        load4(rot, ra);
#pragma unroll 1
        for (int q = 0; q < 32; q += 8) {
            load4((q + 4 + rot) & 31, rb);
            emit4((q + rot) & 31, ra);
            if (q + 8 < 32) load4((q + 8 + rot) & 31, ra);
            emit4((q + 4 + rot) & 31, rb);
        }
    }
}
__device__ __forceinline__ void probe_thrash(const Ctx& C) {
    const u32x4* buf = (const u32x4*)(C.in[I_W1] + (size_t)NE * D * 2 * FF); const size_t n16 = (size_t)512 * MiB / 16; u32x4 acc = {0u, 0u, 0u, 0u};
    for (size_t i = (size_t)C.vcu * NTHREADS + C.tid; i < n16; i += (size_t)C.G * NTHREADS) { const u32x4 v = buf[i]; acc.x ^= v.x; acc.y ^= v.y; acc.z ^= v.z; acc.w ^= v.w; }
    if ((acc.x ^ acc.y ^ acc.z ^ acc.w) == 0x12345679u) C.ctl[CW_TMO + 2] = 1u;
}
constexpr int NPHASE = 20;
__global__ void __launch_bounds__(NTHREADS, 2) k_fwd(Args args) {
    extern __shared__ __attribute__((aligned(16))) unsigned char lds_raw[];
    Ctx C;
    C.lds = (LAS unsigned char*)lds_raw;
    C.tid = threadIdx.x; C.lane = C.tid & 63; C.wave = __builtin_amdgcn_readfirstlane(C.tid >> 6);
    C.G = gridDim.x; { const int bx = blockIdx.x; C.vcu = (C.G % 8 == 0) ? (bx % 8) * (C.G / 8) + bx / 8 : bx; }
    C.in = args.in; C.out = args.out; C.ws = args.ws; C.ctl = (unsigned*)(args.ws + WS_CTL);
    volatile LAS unsigned* MISC = (volatile LAS unsigned*)(C.lds + LDS_MISC);
    if (C.tid < 64) MISC[C.tid] = 0u;
    __syncthreads();
    const int lo = args.lo, hi = args.hi;
    XcdBarrier bar; bar.bar = C.ctl + CW_BAR; bar.x = 0; bar.st = MISC + 8;
    if (hi - lo > 1) bar = xcd_barrier_post(C.ctl + CW_BAR, MISC + 8);
#define IN(k) (lo <= (k) && (k) < hi)
#define SEAM(k) do { if (IN(k) && IN((k) + 1)) xcd_barrier(bar); } while (0)
    if (IN(0)) { for (int rep = 0; rep <= (PROBE_PHASE == 0 ? PROBE_REP : 0); ++rep) { if (rep) { xcd_barrier(bar); if (PROBE_COLD) { probe_thrash(C); xcd_barrier(bar); } if (PROBE_COLD == 2) continue; } ph_ada(C); if (CVT_ITEMS_BF > 0) ph_convert_bf16(C); ph_convert_fp8(C); } } SEAM(0);
    if (IN(1)) { for (int rep = 0; rep <= (PROBE_PHASE == 1 ? PROBE_REP : 0); ++rep) { if (rep) { xcd_barrier(bar); if (PROBE_COLD) { probe_thrash(C); xcd_barrier(bar); } if (PROBE_COLD == 2) continue; } ph_norm0(C); ph_fold_router(C); } } SEAM(1);
    if (IN(2)) { for (int rep = 0; rep <= (PROBE_PHASE == 2 ? PROBE_REP : 0); ++rep) { if (rep) { xcd_barrier(bar); if (PROBE_COLD) { probe_thrash(C); xcd_barrier(bar); } if (PROBE_COLD == 2) continue; } ph_pw1(C); } } SEAM(2);
    if (IN(3)) { for (int rep = 0; rep <= (PROBE_PHASE == 3 ? PROBE_REP : 0); ++rep) { if (rep) { xcd_barrier(bar); if (PROBE_COLD) { probe_thrash(C); xcd_barrier(bar); } if (PROBE_COLD == 2) continue; } { Ctx C2; if (side_ctx(C, NU_DWC, C2)) ph_dwconv(C2); cvt_side(C, NU_DWC, CQ_DWC, 0, cvt_share(NU_PW1, C.G, CQ_PW1)); } } } SEAM(3);
    if (IN(4)) { for (int rep = 0; rep <= (PROBE_PHASE == 4 ? PROBE_REP : 0); ++rep) { if (rep) { xcd_barrier(bar); if (PROBE_COLD) { probe_thrash(C); xcd_barrier(bar); } if (PROBE_COLD == 2) continue; } ph_ln_silu(C); } } SEAM(4);
    if (IN(5)) { for (int rep = 0; rep <= (PROBE_PHASE == 5 ? PROBE_REP : 0); ++rep) { if (rep) { xcd_barrier(bar); if (PROBE_COLD) { probe_thrash(C); xcd_barrier(bar); } if (PROBE_COLD == 2) continue; } ph_pw2(C); } } SEAM(5);
    if (IN(6)) { for (int rep = 0; rep <= (PROBE_PHASE == 6 ? PROBE_REP : 0); ++rep) { if (rep) { xcd_barrier(bar); if (PROBE_COLD) { probe_thrash(C); xcd_barrier(bar); } if (PROBE_COLD == 2) continue; } { Ctx C2; if (side_ctx(C, NU_RT0, C2)) ph_router<false>(C2, 0, C.in[I_X], C.in[I_CTX], TT, WSP(bf16, WS_H1), WSP(bf16, WS_FN0), rep ? 2 : 0); cvt_side(C, NU_RT0, CQ_RT0, 1, 0); } } } SEAM(6);
    if (IN(7)) { for (int rep = 0; rep <= (PROBE_PHASE == 7 ? PROBE_REP : 0); ++rep) { if (rep) { xcd_barrier(bar); if (PROBE_COLD) { probe_thrash(C); xcd_barrier(bar); } if (PROBE_COLD == 2) continue; } ph_moe1(C, 0, WSP(const bf16, WS_FN0), WSP(bf16, WS_ACT0)); } } SEAM(7);
    if (IN(8)) { for (int rep = 0; rep <= (PROBE_PHASE == 8 ? PROBE_REP : 0); ++rep) { if (rep) { xcd_barrier(bar); if (PROBE_COLD) { probe_thrash(C); xcd_barrier(bar); } if (PROBE_COLD == 2) continue; } ph_moe2(C, 0, WSP(const bf16, WS_ACT0), WSP(bf16, WS_Y0)); } } SEAM(8);
    if (IN(9)) { for (int rep = 0; rep <= (PROBE_PHASE == 9 ? PROBE_REP : 0); ++rep) { if (rep) { xcd_barrier(bar); if (PROBE_COLD) { probe_thrash(C); xcd_barrier(bar); } if (PROBE_COLD == 2) continue; } ph_combine(C, 0, WSP(const bf16, WS_H1), WSP(const bf16, WS_Y0), TT, WSP(bf16, WS_H2), WSP(bf16, WS_XN1), nullptr); } } SEAM(9);
    if (IN(10)) { for (int rep = 0; rep <= (PROBE_PHASE == 10 ? PROBE_REP : 0); ++rep) { if (rep) { xcd_barrier(bar); if (PROBE_COLD) { probe_thrash(C); xcd_barrier(bar); } if (PROBE_COLD == 2) continue; } ph_wxy(C); } } SEAM(10);
    if (IN(11)) { for (int rep = 0; rep <= (PROBE_PHASE == 11 ? PROBE_REP : 0); ++rep) { if (rep) { xcd_barrier(bar); if (PROBE_COLD) { probe_thrash(C); xcd_barrier(bar); } if (PROBE_COLD == 2) continue; } ph_lru(C); } } do { if (IN(11) && IN(14)) xcd_barrier(bar); } while (0);
    if (IN(14)) { for (int rep = 0; rep <= (PROBE_PHASE == 14 ? PROBE_REP : 0); ++rep) { if (rep) { xcd_barrier(bar); if (PROBE_COLD) { probe_thrash(C); xcd_barrier(bar); } if (PROBE_COLD == 2) continue; } ph_fixup(C); } } SEAM(14);
    if (IN(15)) { for (int rep = 0; rep <= (PROBE_PHASE == 15 ? PROBE_REP : 0); ++rep) { if (rep) { xcd_barrier(bar); if (PROBE_COLD) { probe_thrash(C); xcd_barrier(bar); } if (PROBE_COLD == 2) continue; } ph_wo(C); } } SEAM(15);
    if (IN(16)) { for (int rep = 0; rep <= (PROBE_PHASE == 16 ? PROBE_REP : 0); ++rep) { if (rep) { xcd_barrier(bar); if (PROBE_COLD) { probe_thrash(C); xcd_barrier(bar); } if (PROBE_COLD == 2) continue; } ph_router<true>(C, 1, WSP(const bf16, WS_H2), WSP(const bf16, WS_H2), TL, WSP(bf16, WS_H3), WSP(bf16, WS_FN1), rep ? 2 : 1); } } SEAM(16);
    if (IN(17)) { for (int rep = 0; rep <= (PROBE_PHASE == 17 ? PROBE_REP : 0); ++rep) { if (rep) { xcd_barrier(bar); if (PROBE_COLD) { probe_thrash(C); xcd_barrier(bar); } if (PROBE_COLD == 2) continue; } ph_moe1(C, 1, WSP(const bf16, WS_FN1), WSP(bf16, WS_ACT1)); } } SEAM(17);
    if (IN(18)) { for (int rep = 0; rep <= (PROBE_PHASE == 18 ? PROBE_REP : 0); ++rep) { if (rep) { xcd_barrier(bar); if (PROBE_COLD) { probe_thrash(C); xcd_barrier(bar); } if (PROBE_COLD == 2) continue; } ph_moe2(C, 1, WSP(const bf16, WS_ACT1), WSP(bf16, WS_Y1)); } } SEAM(18);
    if (IN(19)) { for (int rep = 0; rep <= (PROBE_PHASE == 19 ? PROBE_REP : 0); ++rep) { if (rep) { xcd_barrier(bar); if (PROBE_COLD) { probe_thrash(C); xcd_barrier(bar); } if (PROBE_COLD == 2) continue; } ph_combine(C, 1, WSP(const bf16, WS_H3), WSP(const bf16, WS_Y1), TL, nullptr, nullptr, C.out); } }
#undef IN
#undef SEAM
}

extern "C" void kernel_launch(void* const* d_in, const int* in_sizes, int n_in, void* d_out, int out_size, void* d_ws, size_t ws_size, hipStream_t stream) {
    static int grid = 0;
    if (grid == 0) {
        if (n_in != N_IN || out_size != TL * D || ws_size < WS_END) { fprintf(stderr, "kernel_launch: unexpected problem (n_in %d, out %d, ws %zu < %zu); nothing launched\n", n_in, out_size, ws_size, (size_t)WS_END); grid = -1; return; }
        int dev = 0, cus = 0, per_cu = 0;
        if (hipGetDevice(&dev) != hipSuccess || hipDeviceGetAttribute(&cus, hipDeviceAttributeMultiprocessorCount, dev) != hipSuccess) { grid = -1; return; }
        if (hipFuncSetAttribute((const void*)k_fwd, hipFuncAttributeMaxDynamicSharedMemorySize, LDS_BYTES) != hipSuccess) { fprintf(stderr, "kernel_launch: hipFuncSetAttribute failed\n"); grid = -1; return; }
        if (hipOccupancyMaxActiveBlocksPerMultiprocessor(&per_cu, (const void*)k_fwd, NTHREADS, LDS_BYTES) != hipSuccess || per_cu < 1) { fprintf(stderr, "kernel_launch: occupancy query says %d blocks per CU\n", per_cu); }
        (void)hipGetLastError();
        grid = cus;
    }
    if (grid < 0) return;
    (void)hipMemsetAsync((char*)d_ws + WS_CTL, 0, CTL_ZERO, stream);
    Args a{};
    for (int i = 0; i < N_IN; ++i) a.in[i] = (const float*)d_in[i];
    a.out = (float*)d_out; a.ws = (unsigned char*)d_ws;
#if MK_PER_PHASE
    for (int p = 0; p < NPHASE; ++p) { a.lo = p; a.hi = p + 1; hipLaunchKernelGGL(k_fwd, dim3(grid), dim3(NTHREADS), LDS_BYTES, stream, a); }
#else
    a.lo = 0; a.hi = NPHASE;
    hipLaunchKernelGGL(k_fwd, dim3(grid), dim3(NTHREADS), LDS_BYTES, stream, a);
#endif
    const hipError_t le = hipPeekAtLastError();
    if (le != hipSuccess) fprintf(stderr, "kernel_launch: launch failed: %s\n", hipGetErrorName(le));
}
```

```cpp
#include <hip/hip_runtime.h>
#include <cstdio>
#include <cstdint>

#ifndef MK_PER_PHASE
#define MK_PER_PHASE 0
#endif
#ifndef DENSE_FP8
#define DENSE_FP8 1
#endif
#ifndef PROBE_PHASE
#define PROBE_PHASE -1
#endif
#ifndef PROBE_COLD
#define PROBE_COLD 0
#endif
#ifndef PROBE_REP
#define PROBE_REP 2
#endif

#define GAS __attribute__((address_space(1)))
#define LAS __attribute__((address_space(3)))
typedef unsigned short bf16;
typedef short bf16x8 __attribute__((ext_vector_type(8)));
typedef float f32x4 __attribute__((ext_vector_type(4)));
typedef float f32x2 __attribute__((ext_vector_type(2)));
typedef unsigned u32x4 __attribute__((ext_vector_type(4)));
typedef unsigned u32x2 __attribute__((ext_vector_type(2)));

constexpr int D = 2048, NBATCH = 2, SEQ = 4096, CTXL = 256, GRIDW = 64;
constexpr int TL = NBATCH * SEQ;
constexpr int TC = NBATCH * CTXL;
constexpr int TT = TL + TC;
constexpr int NE = 32, TOPK = 4, FF = 1024;
constexpr int CONVK = 31, CONVP = 15;
constexpr int NHEAD = 16, HBLK = 128;
constexpr float EPS = 1e-6f;
constexpr int NTHREADS = 512, NWAVES = 8;
constexpr int TM = 256;
constexpr int LCAP = TT;
constexpr int ACT_ROWS = TT * TOPK + NE * TM;

enum { I_X = 0, I_C, I_CTX, I_CCTX, I_ADAW, I_ADAB, I_N1G, I_N2G, I_PW1W, I_PW1B, I_DWW, I_DWB, I_LNG, I_LNB, I_PW2W, I_PW2B,
       I_WY, I_BY, I_WX, I_BX, I_LCW, I_LCB, I_WA, I_BA, I_WI, I_BI, I_LAM, I_WO, I_BO, I_RW, I_RB, I_W1, I_B1, I_W2, I_B2, I_FG, N_IN };

constexpr size_t MiB = 1u << 20;
constexpr size_t ALN(size_t x) { return (x + MiB - 1) / MiB * MiB; }
constexpr size_t U16ROWS = (size_t)TT * D * 2;
constexpr size_t F32ROWS = (size_t)TT * D * 4;
constexpr size_t WS_CTL = 0, CTL_BYTES = 1 * MiB, CTL_ZERO = 32768;
constexpr size_t WS_MOD = WS_CTL + CTL_BYTES;
constexpr size_t WS_LIST = WS_MOD + ALN((size_t)2 * 3 * 6 * D * 4);
constexpr size_t WS_PSLOT = WS_LIST + ALN((size_t)3 * NE * LCAP * 4);
constexpr size_t WS_PLIST = WS_PSLOT + ALN((size_t)3 * TT * 4 * 4);
constexpr size_t WS_RWF = WS_PLIST + ALN((size_t)3 * NE * LCAP * 4);
constexpr size_t WS_RC = WS_RWF + ALN((size_t)6 * D * NE * 4);
constexpr size_t WS_DELTA = WS_RC + MiB;
constexpr size_t WS_XN0 = WS_DELTA + ALN(U16ROWS);
constexpr size_t WS_V = WS_XN0 + ALN(U16ROWS);
constexpr size_t WS_CV = WS_V + ALN(U16ROWS);
constexpr size_t WS_A2 = WS_CV + ALN(U16ROWS);
constexpr size_t WS_H1 = WS_A2 + ALN(U16ROWS);
constexpr size_t WS_FN0 = WS_H1 + ALN(F32ROWS);
constexpr size_t WS_ACT0 = WS_FN0 + ALN(U16ROWS);
constexpr size_t WS_Y0 = WS_ACT0 + ALN((size_t)ACT_ROWS * FF * 2);
constexpr size_t WS_H2 = WS_Y0 + ALN((size_t)(TT * 4 + 1024) * D * 2);
constexpr size_t WS_XN1 = WS_H2 + ALN(F32ROWS);
constexpr size_t WS_XB = WS_XN1 + ALN(U16ROWS);
constexpr size_t WS_YL = WS_XB + ALN(U16ROWS);
constexpr size_t WS_XBC = WS_YL + ALN(U16ROWS);
constexpr size_t WS_AARR = WS_XBC + ALN(U16ROWS);
constexpr size_t WS_UARR = WS_AARR + ALN(2 * F32ROWS);
constexpr size_t WS_HL = WS_UARR + ALN(2 * F32ROWS);
constexpr size_t WS_PP = WS_HL + ALN((size_t)2 * TL * D * 2);
constexpr size_t WS_SA = WS_PP + ALN((size_t)2 * TL * D * 2);
constexpr size_t WS_SU = WS_SA + ALN((size_t)136 * 2 * D * 4);
constexpr size_t WS_Z = WS_SU + ALN((size_t)136 * 2 * D * 4);
constexpr size_t WS_H3 = WS_Z + ALN(U16ROWS);
constexpr size_t WS_FN1 = WS_H3 + ALN(F32ROWS);
constexpr size_t WS_ACT1 = WS_FN1 + ALN(U16ROWS);
constexpr size_t WS_Y1 = WS_ACT1 + ALN((size_t)ACT_ROWS * FF * 2);
constexpr size_t WS_WPW1 = WS_Y1 + ALN((size_t)(TT * 4 + 1024) * D * 2);
constexpr size_t WS_WPW2 = WS_WPW1 + ALN((size_t)2 * D * D * 2);
constexpr size_t WS_WXY = WS_WPW2 + ALN((size_t)D * D * 2);
constexpr size_t WS_WWO = WS_WXY + ALN((size_t)2 * D * D * 2);
constexpr size_t WS_WM1 = WS_WWO + ALN((size_t)D * D * 2);
constexpr size_t WS_WM2 = WS_WM1 + ALN((size_t)2 * NE * 2 * FF * D * 2);
constexpr size_t WS_END = WS_WM2 + ALN((size_t)2 * NE * D * FF * 2);

constexpr int CW_TMO = 0;
constexpr int CW_CNT = 1024;
constexpr int CW_BAR = 4096;

constexpr int LDS_BYTES = 163840;
constexpr int LDS_MISC = 151552;
constexpr int LDS_EP = LDS_MISC + 4096;

constexpr float W8_SCALE = 64.0f, W8_INV = 1.0f / 64.0f;
constexpr bool F8_PW1 = (DENSE_FP8 & 1) != 0, F8_PW2 = (DENSE_FP8 & 2) != 0, F8_WXY = (DENSE_FP8 & 4) != 0, F8_WO = (DENSE_FP8 & 8) != 0;
__host__ __device__ constexpr bool dense_tile_f8(int tile) { return tile < 16 ? F8_PW1 : (tile < 24 ? F8_PW2 : (tile < 40 ? F8_WXY : F8_WO)); }
__device__ __forceinline__ unsigned f2bf(float f) { unsigned u = __builtin_bit_cast(unsigned, f); return (u + 0x7fffu + ((u >> 16) & 1u)) >> 16; }
typedef __bf16 bf16x2_hw __attribute__((ext_vector_type(2)));
__device__ __forceinline__ unsigned pk2(float lo, float hi) { const f32x2 f = {lo, hi}; return __builtin_bit_cast(unsigned, __builtin_convertvector(f, bf16x2_hw)); }
__device__ __forceinline__ unsigned pk4_fp8(float a, float b, float c, float d) { int w = 0; w = __builtin_amdgcn_cvt_pk_fp8_f32(a, b, w, false); w = __builtin_amdgcn_cvt_pk_fp8_f32(c, d, w, true); return (unsigned)w; }
__device__ __forceinline__ float bf_lo(unsigned w) { return __builtin_bit_cast(float, w << 16); }
__device__ __forceinline__ float bf_hi(unsigned w) { return __builtin_bit_cast(float, w & 0xffff0000u); }
__device__ __forceinline__ float sigmoidf_(float x) { return __builtin_amdgcn_rcpf(1.0f + __builtin_amdgcn_exp2f(-1.4426950408889634f * x)); }
__device__ __forceinline__ float siluf_(float x) { return x * sigmoidf_(x); }
__device__ __forceinline__ float gelu_tanh(float x) { const float y = 0.7978845608028654f * (x + 0.044715f * x * x * x); const float t = 1.0f - 2.0f * __builtin_amdgcn_rcpf(__builtin_amdgcn_exp2f(2.885390081777927f * y) + 1.0f); return 0.5f * x * (1.0f + t); }
__device__ __forceinline__ float wave_sum(float v) {
#pragma unroll
    for (int o = 1; o < 64; o <<= 1) v += __shfl_xor(v, o);
    return v;
}

#define XB_TMO      128
#define XB_XCNT(j)  (256  + 64 * (j))
#define XB_XSUB(j)  (1280 + 64 * (j))
#define XB_XGEN(j)  (2304 + 64 * (j))
#define XB_TOP      3328
#define XB_TOPGEN   3392
#define XCD_BAR_WORDS 3456
#define XB_SPIN_CAP (1u << 18)

__device__ __forceinline__ unsigned xb_ld(unsigned* p)              { return __hip_atomic_load(p, __ATOMIC_RELAXED, __HIP_MEMORY_SCOPE_AGENT); }
__device__ __forceinline__ unsigned xb_add(unsigned* p, unsigned v) { return __hip_atomic_fetch_add(p, v, __ATOMIC_RELAXED, __HIP_MEMORY_SCOPE_AGENT); }
__device__ __forceinline__ unsigned xb_xcc_id() { return (unsigned)__builtin_amdgcn_s_getreg((3 << 11) | 20) & 0xFu; }
#define XB_SPIN(cond, bar) do { unsigned _sp = 0; while (cond) { __builtin_amdgcn_s_sleep(1); \
    if ((++_sp & 255u) == 0u) { if (xb_ld(&(bar)[XB_TMO])) break; if (_sp > XB_SPIN_CAP) { atomicAdd(&(bar)[XB_TMO], 1u); break; } } } } while (0)

struct XcdBarrier {
    unsigned* bar; unsigned x;
    volatile LAS unsigned* st;
};

__device__ __forceinline__ XcdBarrier xcd_barrier_post(unsigned* bar, volatile LAS unsigned* st) {
    XcdBarrier b; b.bar = bar; b.x = xb_xcc_id(); b.st = st;
    if (threadIdx.x == 0) (void)xb_add(&bar[XB_XCNT(b.x)], 1u);
    return b;
}
__device__ __forceinline__ void xcd_barrier_complete(unsigned* bar, unsigned x, unsigned& nloc, unsigned& nx) {
    const unsigned G = gridDim.x * gridDim.y * gridDim.z;
    unsigned sum, cnt, mine, sp = 0u;
    for (;;) {
        sum = 0u; cnt = 0u; mine = 0u;
#pragma unroll
        for (unsigned j = 0; j < 16; ++j) { const unsigned c = xb_ld(&bar[XB_XCNT(j)]); sum += c; cnt += (c > 0u) ? 1u : 0u; mine = (j == x) ? c : mine; }
        if (sum == G) break;
        __builtin_amdgcn_s_sleep(1);
        if ((++sp & 255u) == 0u) { if (xb_ld(&bar[XB_TMO])) break; if (sp > XB_SPIN_CAP) { atomicAdd(&bar[XB_TMO], 1u); break; } }
    }
    nloc = mine > 0u ? mine : 1u; nx = cnt > 0u ? cnt : 1u;
}

__device__ __forceinline__ void xcd_barrier(const XcdBarrier& b) {
    asm volatile("s_waitcnt vmcnt(0)" ::: "memory");
    __syncthreads();
    if (threadIdx.x == 0) {
        unsigned* bar = b.bar;
        __builtin_amdgcn_s_waitcnt(0);
        unsigned nloc = b.st[0], nx = b.st[1];
        if (nloc == 0u) { xcd_barrier_complete(bar, b.x, nloc, nx); b.st[0] = nloc; b.st[1] = nx; }
        const unsigned old = xb_add(&bar[XB_XSUB(b.x)], 1u);
        const unsigned gen = old / nloc;
        if (old + 1u == (gen + 1u) * nloc) {
            __builtin_amdgcn_fence(__ATOMIC_RELEASE, "agent");
            asm volatile("s_waitcnt vmcnt(0)" ::: "memory");
            const unsigned og = xb_add(&bar[XB_TOP], 1u);
            const unsigned tg = og / nx;
            if (og + 1u == (tg + 1u) * nx) xb_add(&bar[XB_TOPGEN], 1u);
            else XB_SPIN(xb_ld(&bar[XB_TOPGEN]) == tg, bar);
            __builtin_amdgcn_fence(__ATOMIC_ACQUIRE, "agent");
            xb_add(&bar[XB_XGEN(b.x)], 1u);
            asm volatile("s_waitcnt vmcnt(0)" ::: "memory");
        } else {
            XB_SPIN(xb_ld(&bar[XB_XGEN(b.x)]) == gen, bar);
            __builtin_amdgcn_fence(__ATOMIC_ACQUIRE, "agent");
            asm volatile("s_waitcnt vmcnt(0)" ::: "memory");
        }
    }
    __syncthreads();
}

struct Args { const float* in[N_IN]; float* out; unsigned char* ws; int lo, hi; };

struct Ctx {
    LAS unsigned char* lds;
    int tid, lane, wave, vcu, G;
    const float* const* in; float* out; unsigned char* ws;
    unsigned* ctl;
};
#define WSP(T, off) ((T*)(C.ws + (off)))
__device__ __forceinline__ int seg_of_row(int row) { return row < TL ? (row >> 12) : 2; }
__device__ __forceinline__ const float* modp(const Ctx& C, int l, int s, int chunk) { return WSP(const float, WS_MOD) + ((size_t)(l * 3 + s) * 6 + chunk) * D; }

__device__ __forceinline__ void ph_ada(const Ctx& C) {
    LAS float* src = (LAS float*)C.lds;
    LAS float* red = (LAS float*)(C.lds + 32768);
    for (int i = C.tid; i < 3 * D; i += NTHREADS) { const int s = i / D, k = i % D; const float x = s < 2 ? C.in[I_C][s * D + k] : C.in[I_CCTX][k]; src[i] = siluf_(x); }
    __syncthreads();
    const int cq = C.tid & 31, kg = C.tid >> 5;
    for (int u = C.vcu; u < 2 * 96; u += C.G) {
        const int l = u / 96, c0 = (u % 96) * 128;
        const float* Wp = C.in[I_ADAW] + (size_t)l * D * (6 * D) + (size_t)(kg * 128) * (6 * D) + c0 + 4 * cq;
        f32x4 a0 = {0, 0, 0, 0}, a1 = a0, a2 = a0;
#pragma unroll 16
        for (int kk = 0; kk < 128; ++kk) {
            const f32x4 w = __builtin_nontemporal_load((const f32x4*)(Wp + (size_t)kk * (6 * D)));
            const int k = kg * 128 + kk;
            a0 += src[k] * w; a1 += src[D + k] * w; a2 += src[2 * D + k] * w;
        }
        *(LAS f32x4*)(red + (kg * 3 + 0) * 128 + 4 * cq) = a0;
        *(LAS f32x4*)(red + (kg * 3 + 1) * 128 + 4 * cq) = a1;
        *(LAS f32x4*)(red + (kg * 3 + 2) * 128 + 4 * cq) = a2;
        __syncthreads();
        if (C.tid < 384) {
            const int s = C.tid / 128, c = C.tid % 128; float v = C.in[I_ADAB][l * 6 * D + c0 + c];
#pragma unroll
            for (int g = 0; g < 16; ++g) v += red[(g * 3 + s) * 128 + c];
            WSP(float, WS_MOD)[(size_t)(l * 3 + s) * 6 * D + c0 + c] = v;
        }
        __syncthreads();
    }
}

__device__ __forceinline__ void load_row_f32(const float* p, int lane, f32x4 (&x)[8]) {
#pragma unroll
    for (int j = 0; j < 8; ++j) x[j] = *(const f32x4*)(p + 256 * j + 4 * lane);
}
template <bool F8> __device__ __forceinline__ void norm_mod_store(const f32x4 (&x)[8], int lane, LAS const float* va, LAS const float* vb, void* outrow) {
    float ss = 0.f;
#pragma unroll
    for (int j = 0; j < 8; ++j) ss += (x[j].x * x[j].x + x[j].y * x[j].y) + (x[j].z * x[j].z + x[j].w * x[j].w);
    const float rstd = rsqrtf(wave_sum(ss) * (1.0f / D) + EPS);
#pragma unroll
    for (int j = 0; j < 8; ++j) {
        const int k = 256 * j + 4 * lane;
        const f32x4 y = x[j] * rstd * *(LAS const f32x4*)(va + k) + *(LAS const f32x4*)(vb + k);
        if (F8) *(unsigned*)((unsigned char*)outrow + k) = pk4_fp8(y.x, y.y, y.z, y.w);
        else { u32x2 w; w.x = pk2(y.x, y.y); w.y = pk2(y.z, y.w); *(u32x2*)((bf16*)outrow + k) = w; }
    }
}

__device__ __forceinline__ void ph_norm0(const Ctx& C) {
    const int gw = C.vcu * NWAVES + C.wave, NGW = C.G * NWAVES;
    LAS float* VA = (LAS float*)C.lds; LAS float* VB = VA + 3 * D;
    for (int i = C.tid; i < 3 * (D / 4); i += NTHREADS) {
        const int sg = i / (D / 4), k = (i - sg * (D / 4)) * 4;
        *(LAS f32x4*)(VA + sg * D + k) = *(const f32x4*)(C.in[I_N1G] + k) * (1.0f + *(const f32x4*)(modp(C, 0, sg, 1) + k)); *(LAS f32x4*)(VB + sg * D + k) = *(const f32x4*)(modp(C, 0, sg, 0) + k);
    }
    __syncthreads();
    if (gw >= TT) return;
    f32x4 x[8], xn[8];
    { const float* p = gw < TL ? C.in[I_X] + (size_t)gw * D : C.in[I_CTX] + (size_t)(gw - TL) * D; load_row_f32(p, C.lane, x); }
    for (int row = gw; row < TT; row += NGW) {
        const int nrow = row + NGW;
        if (nrow < TT) { const float* p = nrow < TL ? C.in[I_X] + (size_t)nrow * D : C.in[I_CTX] + (size_t)(nrow - TL) * D; load_row_f32(p, C.lane, xn); }
        const int s = seg_of_row(row);
        norm_mod_store<F8_PW1>(x, C.lane, VA + s * D, VB + s * D, WSP(unsigned char, WS_XN0) + (size_t)row * D * (F8_PW1 ? 1 : 2));
#pragma unroll
        for (int j = 0; j < 8; ++j) x[j] = xn[j];
    }
}

struct CvtJob { const float* src; unsigned char* dst; int ld, K, cA, cB; };
__device__ __forceinline__ void cvt_job(const Ctx& C, int tile, CvtJob& j) {
    const int EB = (tile < 48 && dense_tile_f8(tile)) ? 1 : 2;
    if (tile < 16) { j.src = C.in[I_PW1W]; j.ld = 2 * D; j.K = EB * D; j.cA = tile * 128; j.cB = D + tile * 128; j.dst = WSP(unsigned char, WS_WPW1) + (size_t)tile * 256 * D * EB; }
    else if (tile < 24) { const int t = tile - 16; j.src = C.in[I_PW2W]; j.ld = D; j.K = EB * D; j.cA = t * 256; j.cB = j.cA + 128; j.dst = WSP(unsigned char, WS_WPW2) + (size_t)t * 256 * D * EB; }
    else if (tile < 40) { const int t = tile - 24; j.src = t < 8 ? C.in[I_WX] : C.in[I_WY]; j.ld = D; j.K = EB * D; j.cA = (t & 7) * 256; j.cB = j.cA + 128; j.dst = WSP(unsigned char, WS_WXY) + (size_t)t * 256 * D * EB; }
    else if (tile < 48) { const int t = tile - 40; j.src = C.in[I_WO]; j.ld = D; j.K = EB * D; j.cA = t * 256; j.cB = j.cA + 128; j.dst = WSP(unsigned char, WS_WWO) + (size_t)t * 256 * D * EB; }
    else if (tile < 48 + 512) { const int t = tile - 48, le = t >> 3, jt = t & 7; j.src = C.in[I_W1] + (size_t)le * D * (2 * FF); j.ld = 2 * FF; j.K = D; j.cA = jt * 128; j.cB = FF + jt * 128; j.dst = WSP(unsigned char, WS_WM1) + (size_t)t * 256 * D; }
    else { const int t = tile - 560, le = t >> 3, jt = t & 7; j.src = C.in[I_W2] + (size_t)le * FF * D; j.ld = D; j.K = FF; j.cA = jt * 256; j.cB = j.cA + 128; j.dst = WSP(unsigned char, WS_WM2) + (size_t)t * 256 * FF; }
}
constexpr int CVT_TLD = 144;
__device__ __forceinline__ void cvt_flush(const Ctx& C, LAS unsigned char* T, const u32x4 (&w)[4], const CvtJob& j, int kbyte0) {
#pragma unroll
    for (int i = 0; i < 4; ++i) *(LAS u32x4*)(T + (4 * C.lane + i) * CVT_TLD + 16 * C.wave) = w[i];
    __syncthreads();
#pragma unroll
    for (int i = 0; i < 4; ++i) {
        const int c = C.tid + 512 * i, r = c >> 3, pc = c & 7;
        const u32x4 v = *(const LAS u32x4*)(T + r * CVT_TLD + 16 * pc);
        __builtin_nontemporal_store(v, (u32x4*)(j.dst + (size_t)r * j.K + kbyte0 + 16 * pc));
    }
}
__host__ __device__ constexpr int dense_count(bool f8) { int n = 0; for (int t = 0; t < 48; ++t) n += dense_tile_f8(t) == f8 ? 1 : 0; return n; }
__device__ __forceinline__ int dense_tile_of(bool f8, int idx) { int t = 0; for (int n = 0; t < 48; ++t) { if (dense_tile_f8(t) == f8) { if (n == idx) break; ++n; } } return t; }
constexpr int CVT_ITEMS_BF = dense_count(false) * 32, CVT_ITEMS_D8 = dense_count(true) * 16;
__device__ __forceinline__ void cvtb_load(const Ctx& C, int it, f32x4 (&v)[8]) {
    const int tile = dense_tile_of(false, it >> 5), kc = it & 31; CvtJob j; cvt_job(C, tile, j);
    const int col = C.lane < 32 ? j.cA + 4 * C.lane : j.cB + 4 * (C.lane - 32);
    const float* p = j.src + (size_t)(kc * 64 + 8 * C.wave) * j.ld + col;
#pragma unroll
    for (int q = 0; q < 8; ++q) v[q] = *(const f32x4*)(p + (size_t)q * j.ld);
}
__device__ __forceinline__ void ph_convert_bf16(const Ctx& C) {
    int it = C.vcu; if (it >= CVT_ITEMS_BF) return;
    f32x4 va[8], vb[8];
    cvtb_load(C, it, va);
    int buf = 0;
    for (; it < CVT_ITEMS_BF; it += C.G) {
        const bool more = it + C.G < CVT_ITEMS_BF;
        if (more) cvtb_load(C, it + C.G, vb);
        u32x4 w[4];
#pragma unroll
        for (int i = 0; i < 4; ++i) { w[i].x = pk2(va[0][i], va[1][i]); w[i].y = pk2(va[2][i], va[3][i]); w[i].z = pk2(va[4][i], va[5][i]); w[i].w = pk2(va[6][i], va[7][i]); }
        CvtJob j; cvt_job(C, dense_tile_of(false, it >> 5), j);
        cvt_flush(C, C.lds + buf * (256 * CVT_TLD), w, j, (it & 31) * 128);
        buf ^= 1;
        if (more) {
#pragma unroll
            for (int q = 0; q < 8; ++q) va[q] = vb[q];
        }
    }
    __syncthreads();
}
constexpr int CVT_T0 = 48;
constexpr int CVT_ITEMS_W1 = (560 - CVT_T0) * 16, CVT_ITEMS_F8 = CVT_ITEMS_W1 + 512 * 8;
__device__ __forceinline__ void cvt8_decode(int it, int& tile, int& kc) { if (it < CVT_ITEMS_W1) { tile = CVT_T0 + (it >> 4); kc = it & 15; } else if (it < CVT_ITEMS_F8) { const int i2 = it - CVT_ITEMS_W1; tile = 560 + (i2 >> 3); kc = i2 & 7; }
    else { const int i3 = it - CVT_ITEMS_F8; tile = dense_tile_of(true, i3 >> 4); kc = i3 & 15; } }
__device__ __forceinline__ void cvt8_load(const Ctx& C, int it, f32x4 (&v)[16]) {
    int tile, kc; cvt8_decode(it, tile, kc); CvtJob j; cvt_job(C, tile, j);
    const int col = C.lane < 32 ? j.cA + 4 * C.lane : j.cB + 4 * (C.lane - 32);
    const float* p = j.src + (size_t)(kc * 128 + 16 * C.wave) * j.ld + col;
#pragma unroll
    for (int q = 0; q < 16; ++q) v[q] = __builtin_nontemporal_load((const f32x4*)(p + (size_t)q * j.ld));
}
constexpr int CVT_WL = 6144, CVT_DOFF = (48 - CVT_T0) * 16;
__device__ __forceinline__ int cvt8_item_of(int layer, int wi) { return layer == 2 ? CVT_ITEMS_F8 + wi : (wi < 4096 ? CVT_DOFF + layer * 4096 + wi : CVT_ITEMS_W1 + layer * 2048 + (wi - 4096)); }
__device__ __forceinline__ void cvt8_range(const Ctx& C, int layer, int wi_lo, int wi_hi, int rank, int nrank) {
    int wi = wi_lo + rank; if (wi >= wi_hi) return;
    f32x4 va[16], vb[16];
    cvt8_load(C, cvt8_item_of(layer, wi), va);
    int buf = 0;
    for (; wi < wi_hi; wi += nrank) {
        const bool more = wi + nrank < wi_hi;
        if (more) cvt8_load(C, cvt8_item_of(layer, wi + nrank), vb);
        u32x4 w[4];
#pragma unroll
        for (int i = 0; i < 4; ++i) {
            w[i].x = pk4_fp8(va[0][i] * W8_SCALE, va[1][i] * W8_SCALE, va[2][i] * W8_SCALE, va[3][i] * W8_SCALE);
            w[i].y = pk4_fp8(va[4][i] * W8_SCALE, va[5][i] * W8_SCALE, va[6][i] * W8_SCALE, va[7][i] * W8_SCALE);
            w[i].z = pk4_fp8(va[8][i] * W8_SCALE, va[9][i] * W8_SCALE, va[10][i] * W8_SCALE, va[11][i] * W8_SCALE);
            w[i].w = pk4_fp8(va[12][i] * W8_SCALE, va[13][i] * W8_SCALE, va[14][i] * W8_SCALE, va[15][i] * W8_SCALE);
        }
        int tile, kc; cvt8_decode(cvt8_item_of(layer, wi), tile, kc); CvtJob j; cvt_job(C, tile, j);
        cvt_flush(C, C.lds + buf * (256 * CVT_TLD), w, j, kc * 128);
        buf ^= 1;
        if (more) {
#pragma unroll
            for (int q = 0; q < 16; ++q) va[q] = vb[q];
        }
    }
    __syncthreads();
}
constexpr int CQ_PW1 = 20, CQ_PW2 = 24, CQ_WXY = 38, CQ_DWC = 8, CQ_RT0 = 16, CQ_ADA = 5;
constexpr int NU_DWC = (2048 + 2048 + 256) / 8, NU_RT0 = TT / 16;
constexpr int NU_PW1 = (TT / 256) * 16, NU_PW2 = (TT / 256) * 8, NU_WXY = (TT / 256) * 8 + (TL / 256) * 8;
__device__ __forceinline__ int gemm_width(int nunits, int G) { const int r = (nunits + G - 1) / G; int w = (nunits + r - 1) / r; w = (w + 8 - 1) / 8 * 8; return w < G ? w : G; }
__device__ __forceinline__ int cvt_share(int nunits, int G, int q) { return (G - gemm_width(nunits, G)) * q; }
__device__ __forceinline__ int imin(int a, int b) { return a < b ? a : b; }
__device__ __forceinline__ void cvt_side(const Ctx& C, int nunits, int q, int layer, int wi_lo) {
    const int W = gemm_width(nunits, C.G), c = (int)blockIdx.x;
    if (c < W) return;
    cvt8_range(C, layer, imin(wi_lo, CVT_WL), imin(wi_lo + (C.G - W) * q, CVT_WL), c - W, C.G - W);
}
__device__ __forceinline__ bool side_ctx(const Ctx& C, int nunits, Ctx& C2) {
    const int W = gemm_width(nunits, C.G), bx = (int)blockIdx.x;
    C2 = C; C2.G = W; C2.vcu = (W % 8 == 0) ? (bx % 8) * (W / 8) + bx / 8 : bx;
    return bx < W;
}
__device__ __forceinline__ void ph_convert_fp8(const Ctx& C) {
    const int n2 = cvt_share(NU_PW1, C.G, CQ_PW1) + cvt_share(NU_DWC, C.G, CQ_DWC), n5 = cvt_share(NU_PW2, C.G, CQ_PW2), n10 = cvt_share(NU_RT0, C.G, CQ_RT0) + cvt_share(NU_WXY, C.G, CQ_WXY);
    if (CVT_ITEMS_D8 > 0) cvt8_range(C, 2, 0, CVT_ITEMS_D8, C.vcu, C.G);
    cvt8_range(C, 0, imin(n2 + n5, CVT_WL), CVT_WL, C.vcu, C.G);
    const int nada = 2 * 96 < C.G ? 2 * 96 : C.G, nfree = C.G - nada;
    int lo1 = imin(n10, CVT_WL);
    if (nfree > 0) { const int pre = imin(nfree * CQ_ADA, CVT_WL - lo1); if (C.vcu >= nada) cvt8_range(C, 1, lo1, lo1 + pre, C.vcu - nada, nfree); lo1 += pre; }
    cvt8_range(C, 1, lo1, CVT_WL, C.vcu, C.G);
}

namespace pg8 {
constexpr int BM = 256, BK = 64, HALF = 128, HTB = HALF * BK * 2  , STAGE_BYTES = 8 * HTB, NXCD = 8, WGM = 8;
__device__ __forceinline__ int lds_byte(int r, int c) { const int st = (r >> 4) * 2 + (c >> 5), rr = r & 15, cc = c & 31, ob = rr * 64 + cc * 2; return st * 1024 + (ob ^ (((ob >> 9) & 1) << 5)); }
__device__ __forceinline__ void stage_rc(int b, int& R, int& C) { const int st = b / 1024, sb = b % 1024, swz = sb ^ (((sb >> 9) & 1) << 5); R = (st >> 1) * 16 + swz / 64; C = (st & 1) * 32 + (swz % 64) / 2; }
__device__ __forceinline__ int perm32(int rho) { const int n = rho >> 4, i = rho & 15; return 8 * (i >> 2) + 4 * n + (i & 3); }

struct Unit { int pm, pn; const char* a; const char* b; int x0, x1, x2; };

__device__ __forceinline__ void tile_order(int L, int nM, int nN, int& pm, int& pn) {
    const int nwg = nM * nN; int wgid = L; { const int q = nwg / NXCD, r = nwg % NXCD, xcd = wgid % NXCD, off = wgid / NXCD; wgid = (xcd < r ? xcd * (q + 1) : r * (q + 1) + (xcd - r) * q) + off; }
    const int nig = WGM * nN, gid = wgid / nig, fm = gid * WGM, gsz = (nM - fm) < WGM ? (nM - fm) : WGM;
    pm = fm + ((wgid % nig) % gsz); pn = (wgid % nig) / gsz;
}

typedef int i32x4v __attribute__((ext_vector_type(4)));
typedef int i32x8v __attribute__((ext_vector_type(8)));
template <bool FP8> __device__ __forceinline__ void mma_block(f32x4 (&acc)[4][2], const bf16x8 (&At)[4][2], const bf16x8 (&Bt)[2][2]) {
    if constexpr (FP8) {
#pragma unroll
        for (int m = 0; m < 4; ++m)
#pragma unroll
            for (int n = 0; n < 2; ++n) {
                const i32x8v b = __builtin_shufflevector(__builtin_bit_cast(i32x4v, Bt[n][0]), __builtin_bit_cast(i32x4v, Bt[n][1]), 0, 1, 2, 3, 4, 5, 6, 7);
                const i32x8v a = __builtin_shufflevector(__builtin_bit_cast(i32x4v, At[m][0]), __builtin_bit_cast(i32x4v, At[m][1]), 0, 1, 2, 3, 4, 5, 6, 7);
                acc[m][n] = __builtin_amdgcn_mfma_scale_f32_16x16x128_f8f6f4(b, a, acc[m][n], 0, 0, 0, 0x7F7F7F7F, 0, 0x7F7F7F7F);
            }
    } else {
#pragma unroll
        for (int m = 0; m < 4; ++m)
#pragma unroll
            for (int n = 0; n < 2; ++n)
#pragma unroll
                for (int k = 0; k < 2; ++k) acc[m][n] = __builtin_amdgcn_mfma_f32_16x16x32_bf16(Bt[n][k], At[m][k], acc[m][n], 0, 0, 0);
    }
}
template <class Epi, class Sched, bool ALIGN_EPI, bool FP8 = false>
__device__ __forceinline__ void gemm_phase(LAS unsigned char* lds, const int K, const Sched& S, const Epi& E) {
    const int tid = threadIdx.x, wid = __builtin_amdgcn_readfirstlane(tid >> 6), lane = tid & 63, wr = wid >> 2, wc = wid & 3, fr = lane & 15, fq = lane >> 4;
    const int nt = K / BK;
    int Rl[2], Cl[2]; unsigned voffA[2][2], voffB[2];
#pragma unroll
    for (int i = 0; i < 2; ++i) { stage_rc(tid * 16 + i * 8192, Rl[i], Cl[i]); const int Rb = Epi::PERM ? ((Rl[i] & ~31) + perm32(Rl[i] & 31)) : Rl[i]; voffB[i] = (unsigned)(Rb * K + Cl[i]) * 2u; }
    const size_t kstep = (size_t)(BK * 2);
    const size_t hstep = (size_t)HALF * K * 2;
    const unsigned ldsw = (unsigned)wid * 1024u;
    const int aoff = lds_byte(wr * 64 + fr, fq * 8), boff = lds_byte(wc * 32 + fr, fq * 8);
#define PG8_SA(b, h) (((b) * 2 + (h)) * HTB)
#define PG8_SB(b, h) ((4 + (b) * 2 + (h)) * HTB)
#define PG8_STAGE(bufoff, gbase, voff) do { _Pragma("unroll") for (int _i = 0; _i < 2; ++_i) { unsigned _v = (voff)[_i]; asm volatile("" : "+v"(_v));     \
        __builtin_amdgcn_global_load_lds((const unsigned*)((const char*)(gbase) + _v), (LAS unsigned*)(lds + (bufoff) + ldsw + _i * 8192), 16, 0, 0); } } while (0)
#define PG8_LDA(dst, b, h) do { _Pragma("unroll") for (int m = 0; m < 4; ++m) _Pragma("unroll") for (int k = 0; k < 2; ++k) dst[m][k] = *(const LAS bf16x8*)(lds + PG8_SA(b, h) + aoff + m * 2048 + k * 1024); } while (0)
#define PG8_LDB(dst, b, h) do { _Pragma("unroll") for (int n = 0; n < 2; ++n) _Pragma("unroll") for (int k = 0; k < 2; ++k) dst[n][k] = *(const LAS bf16x8*)(lds + PG8_SB(b, h) + boff + n * 2048 + k * 1024); } while (0)
#define PG8_MMA(ai, bj, At, Bt) do { __builtin_amdgcn_s_setprio(1); mma_block<FP8>(acc[ai][bj], At, Bt); __builtin_amdgcn_s_setprio(0); } while (0)
#define PG8_WAIT_V(n) asm volatile("s_waitcnt vmcnt(" #n ")" ::: "memory")
#define PG8_WAIT_L(n) asm volatile("s_waitcnt lgkmcnt(" #n ")" ::: "memory")
#define PG8_BAR __builtin_amdgcn_s_barrier()
#define PG8_SCHED __builtin_amdgcn_sched_barrier(0)
    Unit cur, nxt; int ui = 0;
    if (!S.next(0, cur)) return;
    f32x4 acc[2][2][4][2];
#pragma unroll
    for (int a = 0; a < 2; ++a)
#pragma unroll
        for (int b = 0; b < 2; ++b)
#pragma unroll
            for (int m = 0; m < 4; ++m)
#pragma unroll
                for (int n = 0; n < 2; ++n) acc[a][b][m][n] = (f32x4){0.f, 0.f, 0.f, 0.f};
    bf16x8 At[4][2], B0[2][2], B1[2][2];
    const char* cA = cur.a; const char* cB = cur.b;
    S.first_offsets(cur, K, Rl, Cl, voffA);
    PG8_STAGE(PG8_SB(0, 0), cB, voffB); PG8_STAGE(PG8_SB(0, 1), cB + hstep, voffB); PG8_STAGE(PG8_SA(0, 0), cA, voffA[0]); PG8_STAGE(PG8_SA(0, 1), cA, voffA[1]);
    if (wr == 1) PG8_BAR;
    PG8_WAIT_V(2); PG8_BAR;
    PG8_STAGE(PG8_SB(1, 0), cB + kstep, voffB); PG8_STAGE(PG8_SA(1, 0), cA + kstep, voffA[0]); PG8_STAGE(PG8_SB(1, 1), cB + hstep + kstep, voffB);
    PG8_WAIT_V(6); PG8_BAR;
    for (;;) {
        const bool has_next = S.next(ui + 1, nxt);
        const char* nA = has_next ? nxt.a : cA; const char* nB = has_next ? nxt.b : cB;
        if (has_next) S.prefetch_next(nxt, ui + 1, lds, wid, lane);
        E.prefetch(cur, ui, lds, wid, lane);
#pragma unroll 1
        for (int t = 0; t < nt; t += 2) {
            const bool last = (t == nt - 2);
            const char* a1 = cA + (size_t)(t + 1) * kstep;
            const char* a2 = last ? nA : cA + (size_t)(t + 2) * kstep; const char* b2 = last ? nB : cB + (size_t)(t + 2) * kstep;
            const char* a3 = a2 + kstep; const char* b3 = b2 + kstep;
            PG8_LDB(B0, 0, 0); PG8_LDB(B1, 0, 1); PG8_SCHED; PG8_LDA(At, 0, 0); PG8_STAGE(PG8_SA(1, 1), a1, voffA[1]);
            if (last && has_next) S.next_offsets(nxt, ui + 1, K, Rl, Cl, lds, voffA);
            PG8_WAIT_V(8); PG8_WAIT_L(0); PG8_BAR; PG8_MMA(0, 0, At, B0); PG8_MMA(0, 1, At, B1); PG8_BAR; PG8_SCHED;
            PG8_LDA(At, 0, 1); PG8_STAGE(PG8_SB(0, 0), b2, voffB); PG8_STAGE(PG8_SB(0, 1), b2 + hstep, voffB); PG8_STAGE(PG8_SA(0, 0), a2, voffA[0]);
            PG8_WAIT_V(8); PG8_WAIT_L(0); PG8_BAR; PG8_MMA(1, 0, At, B0); PG8_MMA(1, 1, At, B1); PG8_BAR; PG8_SCHED;
            PG8_LDB(B0, 1, 0); PG8_LDB(B1, 1, 1); PG8_SCHED; PG8_LDA(At, 1, 0); PG8_STAGE(PG8_SA(0, 1), a2, voffA[1]);
            PG8_WAIT_V(8); PG8_WAIT_L(0); PG8_BAR; PG8_MMA(0, 0, At, B0); PG8_MMA(0, 1, At, B1); PG8_BAR; PG8_SCHED;
            PG8_LDA(At, 1, 1); PG8_STAGE(PG8_SB(1, 0), b3, voffB); PG8_STAGE(PG8_SB(1, 1), b3 + hstep, voffB); PG8_STAGE(PG8_SA(1, 0), a3, voffA[0]);
            PG8_WAIT_V(8); PG8_WAIT_L(0); PG8_BAR; PG8_MMA(1, 0, At, B0); PG8_MMA(1, 1, At, B1); PG8_BAR; PG8_SCHED;
        }
        if constexpr (ALIGN_EPI) { if (wr == 0) PG8_BAR; }
        { int tz = threadIdx.x; asm volatile("" : "+v"(tz));
          const int lane2 = tz & 63; E(acc, cur, wr, wc, lane2 & 15, lane2 >> 4, lds, ui); }
        if (!has_next) break;
#pragma unroll
        for (int a = 0; a < 2; ++a)
#pragma unroll
            for (int b = 0; b < 2; ++b)
#pragma unroll
                for (int m = 0; m < 4; ++m)
#pragma unroll
                    for (int n = 0; n < 2; ++n) acc[a][b][m][n] = (f32x4){0.f, 0.f, 0.f, 0.f};
        cur = nxt; cA = nA; cB = nB; ++ui;
        if constexpr (ALIGN_EPI) { if (wr == 1) PG8_BAR; }
    }
    PG8_WAIT_V(0);
    if constexpr (!ALIGN_EPI) { if (wr == 0) PG8_BAR; }
    PG8_BAR;
#undef PG8_SA
#undef PG8_SB
#undef PG8_STAGE
#undef PG8_LDA
#undef PG8_LDB
#undef PG8_MMA
#undef PG8_WAIT_V
#undef PG8_WAIT_L
#undef PG8_BAR
#undef PG8_SCHED
}

struct DenseBase {
    __device__ __forceinline__ void first_offsets(const Unit& u, int K, const int (&Rl)[2], const int (&Cl)[2], unsigned (&voffA)[2][2]) const {
#pragma unroll
        for (int h = 0; h < 2; ++h)
#pragma unroll
            for (int i = 0; i < 2; ++i) voffA[h][i] = (unsigned)((u.pm * BM + h * HALF + Rl[i]) * K + Cl[i]) * 2u;
    }
    __device__ __forceinline__ void prefetch_next(const Unit&, int, LAS unsigned char*, int, int) const {}
    __device__ __forceinline__ void next_offsets(const Unit& n, int, int K, const int (&Rl)[2], const int (&Cl)[2], LAS unsigned char*, unsigned (&voffA)[2][2]) const {
#pragma unroll
        for (int h = 0; h < 2; ++h)
#pragma unroll
            for (int i = 0; i < 2; ++i) voffA[h][i] = (unsigned)((n.pm * BM + h * HALF + Rl[i]) * K + Cl[i]) * 2u;
    }
};
struct DenseOrder : DenseBase {
    const char* A; const char* B; int nM, nN, G, c, K;
    __device__ __forceinline__ bool next(int i, Unit& u) const {
        const long L = (long)i * G + c; if (L >= (long)nM * nN) return false;
        tile_order((int)L, nM, nN, u.pm, u.pn);
        u.a = A; u.b = B + (size_t)u.pn * BM * K * 2; u.x0 = u.x1 = u.x2 = 0; return true;
    }
};
struct WxyOrder : DenseBase {
    const char* A; const char* B; int G, c, K;
    __device__ __forceinline__ bool next(int i, Unit& u) const {
        const long L = (long)i * G + c; constexpr int NXU = (TT / 256) * 8, NYU = (TL / 256) * 8; if (L >= NXU + NYU) return false;
        if (L < NXU) { tile_order((int)L, TT / 256, 8, u.pm, u.pn); } else { tile_order((int)L - NXU, TL / 256, 8, u.pm, u.pn); u.pn += 8; }
        u.a = A; u.b = B + (size_t)u.pn * BM * K * 2; u.x0 = u.x1 = u.x2 = 0; return true;
    }
};
constexpr int MOE_TAB_OFF = LDS_MISC + 1024, MOE_IDX_OFF = LDS_MISC + 2048;
__device__ __forceinline__ bool moe_decode(LAS const int* tab, long L, int NNT, int& ehint, int& e, int& mt, int& nt) {
    const int nwg = __builtin_amdgcn_readfirstlane(tab[64]) * NNT; if (L >= nwg) return false;
    int w = (int)L; { const int q = nwg / NXCD, r = nwg % NXCD, xcd = w % NXCD, off = w / NXCD; w = (xcd < r ? xcd * (q + 1) : r * (q + 1) + (xcd - r) * q) + off; }
    e = ehint; while (e < NE - 1 && w >= __builtin_amdgcn_readfirstlane(tab[32 + e + 1]) * NNT) ++e;
    ehint = e;
    const int t0 = __builtin_amdgcn_readfirstlane(tab[32 + e]), t1 = __builtin_amdgcn_readfirstlane(tab[32 + e + 1]);
    const int wl = w - t0 * NNT, te = t1 - t0;
    nt = wl / te; mt = wl - nt * te; return true;
}
struct Moe1Order {
    const char* FN; const char* W; const int* list; LAS const int* tab; int G, c; mutable int ehint;
    __device__ __forceinline__ bool next(int i, Unit& u) const {
        int e, mt, nt; if (!moe_decode(tab, (long)i * G + c, 8, ehint, e, mt, nt)) return false;
        u.pm = __builtin_amdgcn_readfirstlane(tab[32 + e]) + mt; u.pn = nt; u.x0 = e; u.x1 = mt; u.x2 = __builtin_amdgcn_readfirstlane(tab[e]);
        u.a = FN; u.b = W + ((size_t)e * 8 + nt) * BM * D; return true;
    }
    __device__ __forceinline__ void first_offsets(const Unit& u, int K, const int (&Rl)[2], const int (&Cl)[2], unsigned (&voffA)[2][2]) const {
        const int* le = list + (size_t)u.x0 * LCAP + u.x1 * 256;
#pragma unroll
        for (int h = 0; h < 2; ++h)
#pragma unroll
            for (int i = 0; i < 2; ++i) { const int r = h * HALF + Rl[i]; const int tok = (u.x1 * 256 + r < u.x2) ? (le[r] >> 2) : 0; voffA[h][i] = (unsigned)(tok * K + Cl[i]) * 2u; }
    }
    __device__ __forceinline__ void prefetch_next(const Unit& n, int ui, LAS unsigned char* lds, int wid, int lane) const {
        if (wid < 4) { const int* src = list + (size_t)n.x0 * LCAP + n.x1 * 256 + wid * 64 + lane;
            __builtin_amdgcn_global_load_lds((const unsigned*)src, (LAS unsigned*)(lds + MOE_IDX_OFF + (ui & 1) * 1024 + wid * 256), 4, 0, 0); }
    }
    __device__ __forceinline__ void next_offsets(const Unit& n, int ui, int K, const int (&Rl)[2], const int (&Cl)[2], LAS unsigned char* lds, unsigned (&voffA)[2][2]) const {
        LAS const int* idx = (LAS const int*)(lds + MOE_IDX_OFF + (ui & 1) * 1024);
#pragma unroll
        for (int h = 0; h < 2; ++h)
#pragma unroll
            for (int i = 0; i < 2; ++i) { const int r = h * HALF + Rl[i]; const int v = idx[r]; const int tok = (n.x1 * 256 + r < n.x2) ? (v >> 2) : 0; voffA[h][i] = (unsigned)(tok * K + Cl[i]) * 2u; }
    }
};
struct Moe2Order {
    const char* ACT; const char* W; LAS const int* tab; int G, c; mutable int ehint;
    __device__ __forceinline__ bool next(int i, Unit& u) const {
        int e, mt, nt; if (!moe_decode(tab, (long)i * G + c, 8, ehint, e, mt, nt)) return false;
        u.pm = __builtin_amdgcn_readfirstlane(tab[32 + e]) + mt; u.pn = nt; u.x0 = e; u.x1 = mt; u.x2 = __builtin_amdgcn_readfirstlane(tab[e]);
        u.a = ACT; u.b = W + ((size_t)e * 8 + nt) * BM * FF; return true;
    }
    __device__ __forceinline__ void first_offsets(const Unit& u, int K, const int (&Rl)[2], const int (&Cl)[2], unsigned (&voffA)[2][2]) const {
#pragma unroll
        for (int h = 0; h < 2; ++h)
#pragma unroll
            for (int i = 0; i < 2; ++i) voffA[h][i] = (unsigned)((u.pm * BM + h * HALF + Rl[i]) * K + Cl[i]) * 2u;
    }
    __device__ __forceinline__ void prefetch_next(const Unit&, int, LAS unsigned char*, int, int) const {}
    __device__ __forceinline__ void next_offsets(const Unit& n, int, int K, const int (&Rl)[2], const int (&Cl)[2], LAS unsigned char*, unsigned (&voffA)[2][2]) const {
#pragma unroll
        for (int h = 0; h < 2; ++h)
#pragma unroll
            for (int i = 0; i < 2; ++i) voffA[h][i] = (unsigned)((n.pm * BM + h * HALF + Rl[i]) * K + Cl[i]) * 2u;
    }
};
}

__device__ __forceinline__ int seg_of_tile(int pm) { return pm < 16 ? 0 : (pm < 32 ? 1 : 2); }
__device__ __forceinline__ void ep_dma(LAS unsigned char* lds, int ui, int word_off, const void* src_word0, int wid, int lane) {
    __builtin_amdgcn_global_load_lds((const unsigned*)src_word0 + wid * 64 + lane, (LAS unsigned*)(lds + LDS_EP + (ui & 1) * 4096 + (word_off + wid * 64) * 4), 4, 0, 0);
}
template <int MODE  > struct EpiGlu {
    static constexpr bool PERM = true;
    bf16* O; int ldo; const float* Bv; const float* Bg; int bstride; float asc;
    __device__ __forceinline__ void prefetch(const pg8::Unit& u, int ui, LAS unsigned char* lds, int wid, int lane) const {
        if (wid < 4) { const float* src = (wid < 2 ? Bv : Bg) + (size_t)u.x0 * bstride + u.pn * 128 - (wid < 2 ? 0 : 128); ep_dma(lds, ui, 0, src, wid, lane); }
    }
    __device__ __forceinline__ void operator()(const f32x4 (&acc)[2][2][4][2], const pg8::Unit& u, int wr, int wc, int fr, int fq, LAS unsigned char* lds, int ui) const {
        const int row0 = u.pm * 256 + wr * 64 + fr, cl = wc * 32 + 8 * fq, col0 = u.pn * 128 + cl;
        LAS const float* P = (LAS const float*)(lds + LDS_EP + (ui & 1) * 4096);
        const f32x4 bv0 = *(LAS const f32x4*)(P + cl), bv1 = *(LAS const f32x4*)(P + cl + 4), bg0 = *(LAS const f32x4*)(P + 128 + cl), bg1 = *(LAS const f32x4*)(P + 128 + cl + 4);
        const float sc = asc;
#pragma unroll
        for (int ai = 0; ai < 2; ++ai)
#pragma unroll
            for (int m = 0; m < 4; ++m) {
                const f32x4 a0 = acc[ai][0][m][0] * sc + bv0, a1 = acc[ai][0][m][1] * sc + bv1, g0 = acc[ai][1][m][0] * sc + bg0, g1 = acc[ai][1][m][1] * sc + bg1;
                float o[8];
                if (MODE == 0) {
#pragma unroll
                    for (int i = 0; i < 4; ++i) { o[i] = a0[i] * sigmoidf_(g0[i]); o[4 + i] = a1[i] * sigmoidf_(g1[i]); }
                } else {
#pragma unroll
                    for (int i = 0; i < 4; i += 2) {
#pragma unroll
                        for (int hf = 0; hf < 2; ++hf) {
                            const f32x4& av = hf ? a1 : a0; const f32x4& gv = hf ? g1 : g0;
                            f32x2 x = {fminf(av[i], 7.0f), fminf(av[i + 1], 7.0f)};
                            f32x2 y = {fminf(fmaxf(gv[i], -7.0f), 7.0f), fminf(fmaxf(gv[i + 1], -7.0f), 7.0f)};
                            const f32x2 t = x * (-1.702f * 1.4426950408889634f);
                            f32x2 e; e.x = __builtin_amdgcn_exp2f(t.x); e.y = __builtin_amdgcn_exp2f(t.y);
                            e = e + 1.0f;
                            f32x2 r; r.x = __builtin_amdgcn_rcpf(e.x); r.y = __builtin_amdgcn_rcpf(e.y);
                            const f32x2 ov = (x * (y + 1.0f)) * r;
                            o[4 * hf + i] = ov.x; o[4 * hf + i + 1] = ov.y;
                        }
                    }
                }
                if (MODE == 0) {
                    u32x4 w; w.x = pk2(o[0], o[1]); w.y = pk2(o[2], o[3]); w.z = pk2(o[4], o[5]); w.w = pk2(o[6], o[7]);
                    *(u32x4*)(O + (size_t)(row0 + ai * 128 + m * 16) * ldo + col0) = w;
                } else {
                    u32x2 w; w.x = pk4_fp8(o[0], o[1], o[2], o[3]); w.y = pk4_fp8(o[4], o[5], o[6], o[7]);
                    *(u32x2*)((unsigned char*)O + (size_t)(row0 + ai * 128 + m * 16) * ldo + col0) = w;
                }
            }
    }
};
struct EpiDelta {
    static constexpr bool PERM = true;
    bf16* O; const float* bias; const float* gate; float asc;
    __device__ __forceinline__ void prefetch(const pg8::Unit& u, int ui, LAS unsigned char* lds, int wid, int lane) const {
        const float* src = wid < 4 ? bias + u.pn * 256 : gate + (size_t)seg_of_tile(u.pm) * 6 * D + u.pn * 256 - 256; ep_dma(lds, ui, 0, src, wid, lane);
    }
    __device__ __forceinline__ void operator()(const f32x4 (&acc)[2][2][4][2], const pg8::Unit& u, int wr, int wc, int fr, int fq, LAS unsigned char* lds, int ui) const {
        const int row0 = u.pm * 256 + wr * 64 + fr, cl = wc * 32 + 8 * fq, col0 = u.pn * 256 + cl;
        LAS const float* P = (LAS const float*)(lds + LDS_EP + (ui & 1) * 4096);
        f32x4 bv[2][2], gv[2][2];
#pragma unroll
        for (int bj = 0; bj < 2; ++bj)
#pragma unroll
            for (int n = 0; n < 2; ++n) { bv[bj][n] = *(LAS const f32x4*)(P + cl + bj * 128 + 4 * n); gv[bj][n] = *(LAS const f32x4*)(P + 256 + cl + bj * 128 + 4 * n); }
#pragma unroll
        for (int ai = 0; ai < 2; ++ai)
#pragma unroll
            for (int m = 0; m < 4; ++m)
#pragma unroll
                for (int bj = 0; bj < 2; ++bj) {
                    const f32x4 v0 = gv[bj][0] * (acc[ai][bj][m][0] * asc + bv[bj][0]), v1 = gv[bj][1] * (acc[ai][bj][m][1] * asc + bv[bj][1]);
                    u32x4 w; w.x = pk2(v0[0], v0[1]); w.y = pk2(v0[2], v0[3]); w.z = pk2(v1[0], v1[1]); w.w = pk2(v1[2], v1[3]);
                    *(u32x4*)(O + (size_t)(row0 + ai * 128 + m * 16) * D + col0 + bj * 128) = w;
                }
    }
};
struct EpiWxy {
    static constexpr bool PERM = true;
    bf16* XB; bf16* YL; const float* bx; const float* by; float asc;
    __device__ __forceinline__ void prefetch(const pg8::Unit& u, int ui, LAS unsigned char* lds, int wid, int lane) const {
        if (wid < 4) ep_dma(lds, ui, 0, (u.pn >= 8 ? by : bx) + (u.pn & 7) * 256, wid, lane);
    }
    __device__ __forceinline__ void operator()(const f32x4 (&acc)[2][2][4][2], const pg8::Unit& u, int wr, int wc, int fr, int fq, LAS unsigned char* lds, int ui) const {
        const bool isy = u.pn >= 8; const int pn = u.pn & 7; bf16* O = isy ? YL : XB;
        const int row0 = u.pm * 256 + wr * 64 + fr, cl = wc * 32 + 8 * fq, col0 = pn * 256 + cl;
        LAS const float* P = (LAS const float*)(lds + LDS_EP + (ui & 1) * 4096);
        f32x4 bv[2][2];
#pragma unroll
        for (int bj = 0; bj < 2; ++bj)
#pragma unroll
            for (int n = 0; n < 2; ++n) bv[bj][n] = *(LAS const f32x4*)(P + cl + bj * 128 + 4 * n);
#pragma unroll
        for (int ai = 0; ai < 2; ++ai)
#pragma unroll
            for (int m = 0; m < 4; ++m)
#pragma unroll
                for (int bj = 0; bj < 2; ++bj) {
                    f32x4 v0 = acc[ai][bj][m][0] * asc + bv[bj][0], v1 = acc[ai][bj][m][1] * asc + bv[bj][1];
                    if (isy) {
#pragma unroll
                        for (int i = 0; i < 4; ++i) { v0[i] = gelu_tanh(v0[i]); v1[i] = gelu_tanh(v1[i]); } }
                    u32x4 w; w.x = pk2(v0[0], v0[1]); w.y = pk2(v0[2], v0[3]); w.z = pk2(v1[0], v1[1]); w.w = pk2(v1[2], v1[3]);
                    *(u32x4*)(O + (size_t)(row0 + ai * 128 + m * 16) * D + col0 + bj * 128) = w;
                }
    }
};
struct EpiMoe2 {
    static constexpr bool PERM = true;
    bf16* Y; const float* B2; const int* list; const float* plist;
    __device__ __forceinline__ void prefetch(const pg8::Unit& u, int ui, LAS unsigned char* lds, int wid, int lane) const {
        const size_t lo = (size_t)u.x0 * LCAP + u.x1 * 256;
        if (wid < 4) { ep_dma(lds, ui, 0, B2 + (size_t)u.x0 * D + u.pn * 256, wid, lane); ep_dma(lds, ui, 512, plist + lo, wid, lane); }
        else ep_dma(lds, ui, 0, list + lo - 256, wid, lane);
    }
    __device__ __forceinline__ void operator()(const f32x4 (&acc)[2][2][4][2], const pg8::Unit& u, int wr, int wc, int fr, int fq, LAS unsigned char* lds, int ui) const {
        const int nvalid = u.x2 - u.x1 * 256;
        const int cl = wc * 32 + 8 * fq, col0 = u.pn * 256 + cl;
        LAS const float* P = (LAS const float*)(lds + LDS_EP + (ui & 1) * 4096); LAS const int* SL = (LAS const int*)(P + 256); LAS const float* PL = P + 512;
        f32x4 bv[2][2];
#pragma unroll
        for (int bj = 0; bj < 2; ++bj)
#pragma unroll
            for (int n = 0; n < 2; ++n) bv[bj][n] = *(LAS const f32x4*)(P + cl + bj * 128 + 4 * n);
#pragma unroll
        for (int ai = 0; ai < 2; ++ai)
#pragma unroll
            for (int m = 0; m < 4; ++m) {
                const int r = ai * 128 + wr * 64 + m * 16 + fr; const bool ok = r < nvalid;
                const int slot = ok ? SL[r] : TT * 4 + (((int)blockIdx.x * 4 + m + 4 * ai + fr * 8) & 1023);
                const float p = ok ? PL[r] : 0.0f;
#pragma unroll
                for (int bj = 0; bj < 2; ++bj) {
                    const f32x4 v0 = (acc[ai][bj][m][0] * W8_INV + bv[bj][0]) * p, v1 = (acc[ai][bj][m][1] * W8_INV + bv[bj][1]) * p;
                    u32x2 w; w.x = pk4_fp8(v0[0], v0[1], v0[2], v0[3]); w.y = pk4_fp8(v1[0], v1[1], v1[2], v1[3]);
                    *(u32x2*)((unsigned char*)Y + (size_t)slot * D + col0 + bj * 128) = w;
                }
            }
    }
};

__device__ __forceinline__ void ph_pw1(const Ctx& C) {
    pg8::DenseOrder S; S.A = (const char*)WSP(const bf16, WS_XN0); S.B = (const char*)WSP(const bf16, WS_WPW1); S.nM = TT / 256; S.nN = 16; S.G = gemm_width(NU_PW1, C.G); S.c = (int)blockIdx.x; S.K = F8_PW1 ? D / 2 : D;
    EpiGlu<0> E{WSP(bf16, WS_V), D, C.in[I_PW1B], C.in[I_PW1B] + D, 0, F8_PW1 ? W8_INV : 1.0f};
    if (S.c < S.G) pg8::gemm_phase<EpiGlu<0>, pg8::DenseOrder, true, F8_PW1>(C.lds, F8_PW1 ? D / 2 : D, S, E);
    cvt_side(C, NU_PW1, CQ_PW1, 0, 0);
}
__device__ __forceinline__ void ph_pw2(const Ctx& C) {
    pg8::DenseOrder S; S.A = (const char*)WSP(const bf16, WS_A2); S.B = (const char*)WSP(const bf16, WS_WPW2); S.nM = TT / 256; S.nN = 8; S.G = gemm_width(NU_PW2, C.G); S.c = (int)blockIdx.x; S.K = F8_PW2 ? D / 2 : D;
    EpiDelta E{WSP(bf16, WS_DELTA), C.in[I_PW2B], modp(C, 0, 0, 2), F8_PW2 ? W8_INV : 1.0f};
    if (S.c < S.G) pg8::gemm_phase<EpiDelta, pg8::DenseOrder, true, F8_PW2>(C.lds, F8_PW2 ? D / 2 : D, S, E);
    cvt_side(C, NU_PW2, CQ_PW2, 0, cvt_share(NU_PW1, C.G, CQ_PW1) + cvt_share(NU_DWC, C.G, CQ_DWC));
}
__device__ __forceinline__ void moe_table(const Ctx& C, int layer, LAS int* tab) {
    if (C.tid < 64) {
        const int e = C.lane & 31;
        const int c = (int)__hip_atomic_load(C.ctl + CW_CNT + layer * 64 + e, __ATOMIC_RELAXED, __HIP_MEMORY_SCOPE_AGENT);
        const int tiles = (c + TM - 1) / TM; int incl = tiles;
#pragma unroll
        for (int o = 1; o < 32; o <<= 1) { const int v = __shfl_up(incl, o, 32); if (e >= o) incl += v; }
        if (C.lane < 32) { tab[e] = c; tab[32 + e] = incl - tiles; if (e == 31) tab[64] = incl; }
    }
    __syncthreads();
}
__device__ __forceinline__ void ph_moe1(const Ctx& C, int layer, const bf16* FN, bf16* ACT) {
    LAS int* tab = (LAS int*)(C.lds + pg8::MOE_TAB_OFF);
    moe_table(C, layer, tab);
    pg8::Moe1Order S; S.FN = (const char*)FN; S.W = (const char*)(WSP(const unsigned char, WS_WM1) + (size_t)layer * NE * 2 * FF * D);
    S.list = WSP(const int, WS_LIST) + (size_t)layer * NE * LCAP; S.tab = tab; S.G = C.G; S.c = (int)blockIdx.x; S.ehint = 0;
    const float* B1 = C.in[I_B1] + (size_t)layer * NE * 2 * FF;
    EpiGlu<1> E{ACT, FF, B1, B1 + FF, 2 * FF, W8_INV};
    pg8::gemm_phase<EpiGlu<1>, pg8::Moe1Order, true, true>(C.lds, D / 2, S, E);
}
__device__ __forceinline__ void ph_moe2(const Ctx& C, int layer, const bf16* ACT, bf16* Y) {
    LAS int* tab = (LAS int*)(C.lds + pg8::MOE_TAB_OFF);
    moe_table(C, layer, tab);
    pg8::Moe2Order S; S.ACT = (const char*)ACT; S.W = (const char*)(WSP(const unsigned char, WS_WM2) + (size_t)layer * NE * D * FF); S.tab = tab; S.G = C.G; S.c = (int)blockIdx.x; S.ehint = 0;
    EpiMoe2 E{Y, C.in[I_B2] + (size_t)layer * NE * D, WSP(const int, WS_LIST) + (size_t)layer * NE * LCAP, WSP(const float, WS_PLIST) + (size_t)layer * NE * LCAP};
    pg8::gemm_phase<EpiMoe2, pg8::Moe2Order, true, true>(C.lds, FF / 2, S, E);
}
__device__ __forceinline__ void ph_wxy(const Ctx& C) {
    pg8::WxyOrder S; S.A = (const char*)WSP(const bf16, WS_XN1); S.B = (const char*)WSP(const bf16, WS_WXY); S.G = gemm_width(NU_WXY, C.G); S.c = (int)blockIdx.x; S.K = F8_WXY ? D / 2 : D;
    EpiWxy E{WSP(bf16, WS_XB), WSP(bf16, WS_YL), C.in[I_BX], C.in[I_BY], F8_WXY ? W8_INV : 1.0f};
    if (S.c < S.G) pg8::gemm_phase<EpiWxy, pg8::WxyOrder, true, F8_WXY>(C.lds, F8_WXY ? D / 2 : D, S, E);
    cvt_side(C, NU_WXY, CQ_WXY, 1, cvt_share(NU_RT0, C.G, CQ_RT0));
}
__device__ __forceinline__ void ph_wo(const Ctx& C) {
    pg8::DenseOrder S; S.A = (const char*)WSP(const bf16, WS_Z); S.B = (const char*)WSP(const bf16, WS_WWO); S.nM = TL / 256; S.nN = 8; S.G = C.G; S.c = (int)blockIdx.x; S.K = F8_WO ? D / 2 : D;
    EpiDelta E{WSP(bf16, WS_DELTA), C.in[I_BO], modp(C, 1, 0, 2), F8_WO ? W8_INV : 1.0f};
    pg8::gemm_phase<EpiDelta, pg8::DenseOrder, true, F8_WO>(C.lds, F8_WO ? D / 2 : D, S, E);
}

__device__ __forceinline__ void ph_dwconv(const Ctx& C) {
    const bf16* V = WSP(const bf16, WS_V); bf16* CV = WSP(bf16, WS_CV);
    const float* Wt = C.in[I_DWW]; const float* Bi = C.in[I_DWB];
    const int gw = C.vcu * NWAVES + C.wave, NGW = C.G * NWAVES;
    LAS unsigned char* T = C.lds + C.wave * 16384;
    constexpr int NTASK = 2048 + 2048 + 256;
    for (int task = gw; task < NTASK; task += NGW) {
        int tb, ps, pbase, L, ch0;
        if (task < 2048) { const int hf = task & 1, cg = (task >> 1) & 7, sq = task >> 4; tb = sq * 64; ps = 1; pbase = hf * 32; L = 64; ch0 = cg * 128; }
        else if (task < 4096) { const int i2 = task - 2048, hf = i2 & 1, cg = (i2 >> 1) & 7, cid = i2 >> 4; tb = (cid >> 6) * SEQ + (cid & 63); ps = 64; pbase = hf * 32; L = 64; ch0 = 1024 + cg * 128; }
        else { const int i3 = task - 4096, cg = i3 & 15, sp = i3 >> 4; tb = TL + (sp >> 3) * CTXL; ps = 1; pbase = (sp & 7) * 32; L = CTXL; ch0 = cg * 128; }
#pragma unroll
        for (int i = 0; i < 16; ++i) {
            int p = pbase - CONVP + 4 * i + (C.lane >> 4); p = p < 0 ? 0 : (p >= L ? L - 1 : p);
            const bf16* src = V + (size_t)(tb + p * ps) * D + ch0 + (C.lane & 15) * 8;
            __builtin_amdgcn_global_load_lds((const unsigned*)src, (LAS unsigned*)(T + i * 1024), 16, 0, 0);
        }
        const int ch = ch0 + 2 * C.lane;
        float w0[CONVK], w1[CONVK];
#pragma unroll
        for (int j = 0; j < CONVK; ++j) { const f32x2 w = *(const f32x2*)(Wt + (size_t)j * D + ch); w0[j] = w.x; w1[j] = w.y; }
        const f32x2 bb = *(const f32x2*)(Bi + ch);
        float r0[CONVK], r1[CONVK];
        asm volatile("s_waitcnt vmcnt(0)" ::: "memory");
#pragma unroll
        for (int q = 0; q < CONVK - 1; ++q) {
            const int p = pbase - CONVP + q; float x0 = 0.f, x1 = 0.f;
            if (p >= 0 && p < L) { const unsigned w = *(const LAS unsigned*)(T + q * 256 + 4 * C.lane); x0 = bf_lo(w); x1 = bf_hi(w); }
            r0[q % CONVK] = x0; r1[q % CONVK] = x1;
        }
#pragma unroll
        for (int o = 0; o < 32; ++o) {
            { const int q = o + CONVK - 1; const int p = pbase - CONVP + q; float x0 = 0.f, x1 = 0.f;
              if (p >= 0 && p < L) { const unsigned w = *(const LAS unsigned*)(T + q * 256 + 4 * C.lane); x0 = bf_lo(w); x1 = bf_hi(w); }
              r0[q % CONVK] = x0; r1[q % CONVK] = x1; }
            float s0 = bb.x, s1 = bb.y;
#pragma unroll
            for (int j = 0; j < CONVK; ++j) { s0 += w0[j] * r0[(o + j) % CONVK]; s1 += w1[j] * r1[(o + j) % CONVK]; }
            *(unsigned*)(CV + (size_t)(tb + (pbase + o) * ps) * D + ch) = pk2(s0, s1);
        }
        asm volatile("s_waitcnt lgkmcnt(0)" ::: "memory");
    }
}

__device__ __forceinline__ void ph_ln_silu(const Ctx& C) {
    const bf16* CV = WSP(const bf16, WS_CV); bf16* A2 = WSP(bf16, WS_A2);
    const float* G = C.in[I_LNG]; const float* Bv = C.in[I_LNB];
    const int gw = C.vcu * NWAVES + C.wave, NGW = C.G * NWAVES;
    LAS float* VG = (LAS float*)C.lds; LAS float* VB = VG + D;
    for (int i = C.tid; i < D / 4; i += NTHREADS) { *(LAS f32x4*)(VG + 4 * i) = *(const f32x4*)(G + 4 * i); *(LAS f32x4*)(VB + 4 * i) = *(const f32x4*)(Bv + 4 * i); }
    __syncthreads();
    if (gw >= TT) return;
    u32x4 wc[4], wn[4];
#pragma unroll
    for (int j = 0; j < 4; ++j) wc[j] = __builtin_nontemporal_load((const u32x4*)(CV + (size_t)gw * D + 8 * (64 * j + C.lane)));
    for (int row = gw; row < TT; row += NGW) {
        if (row + NGW < TT) {
#pragma unroll
            for (int j = 0; j < 4; ++j) wn[j] = __builtin_nontemporal_load((const u32x4*)(CV + (size_t)(row + NGW) * D + 8 * (64 * j + C.lane)));
        }
        float x[32]; float s = 0.f;
#pragma unroll
        for (int j = 0; j < 4; ++j) {
            const u32x4 w = wc[j];
            x[8 * j + 0] = bf_lo(w.x); x[8 * j + 1] = bf_hi(w.x); x[8 * j + 2] = bf_lo(w.y); x[8 * j + 3] = bf_hi(w.y);
            x[8 * j + 4] = bf_lo(w.z); x[8 * j + 5] = bf_hi(w.z); x[8 * j + 6] = bf_lo(w.w); x[8 * j + 7] = bf_hi(w.w);
        }
#pragma unroll
        for (int i = 0; i < 32; ++i) s += x[i];
        const float mean = wave_sum(s) * (1.0f / D); float q = 0.f;
#pragma unroll
        for (int i = 0; i < 32; ++i) { x[i] -= mean; q += x[i] * x[i]; }
        const float rstd = rsqrtf(wave_sum(q) * (1.0f / D) + EPS);
#pragma unroll
        for (int j = 0; j < 4; ++j) {
            const int k = 8 * (64 * j + C.lane);
            const f32x4 g0 = *(LAS const f32x4*)(VG + k), g1 = *(LAS const f32x4*)(VG + k + 4), b0 = *(LAS const f32x4*)(VB + k), b1 = *(LAS const f32x4*)(VB + k + 4);
            float y[8];
            y[0] = x[8 * j + 0] * rstd * g0.x + b0.x; y[1] = x[8 * j + 1] * rstd * g0.y + b0.y; y[2] = x[8 * j + 2] * rstd * g0.z + b0.z; y[3] = x[8 * j + 3] * rstd * g0.w + b0.w;
            y[4] = x[8 * j + 4] * rstd * g1.x + b1.x; y[5] = x[8 * j + 5] * rstd * g1.y + b1.y; y[6] = x[8 * j + 6] * rstd * g1.z + b1.z; y[7] = x[8 * j + 7] * rstd * g1.w + b1.w;
            if (F8_PW2) { u32x2 w; w.x = pk4_fp8(siluf_(y[0]), siluf_(y[1]), siluf_(y[2]), siluf_(y[3])); w.y = pk4_fp8(siluf_(y[4]), siluf_(y[5]), siluf_(y[6]), siluf_(y[7]));
                *(u32x2*)((unsigned char*)A2 + (size_t)row * D + k) = w; }
            else { u32x4 w; w.x = pk2(siluf_(y[0]), siluf_(y[1])); w.y = pk2(siluf_(y[2]), siluf_(y[3])); w.z = pk2(siluf_(y[4]), siluf_(y[5])); w.w = pk2(siluf_(y[6]), siluf_(y[7]));
                *(u32x4*)(A2 + (size_t)row * D + k) = w; }
        }
#pragma unroll
        for (int j = 0; j < 4; ++j) wc[j] = wn[j];
    }
}

__device__ __forceinline__ void ph_fold_router(const Ctx& C) {
    float* RWF = WSP(float, WS_RWF); float* RC = WSP(float, WS_RC);
    const int gt = C.vcu * NTHREADS + C.tid, NGT = C.G * NTHREADS;
    for (int i = gt; i < 6 * D * NE / 4; i += NGT) {
        const int ls = i / (D * NE / 4), r = i % (D * NE / 4), k = r / (NE / 4), l = ls / 3, s = ls % 3;
        const float al = C.in[I_N2G][l * D + k] * (1.0f + modp(C, l, s, 4)[k]);
        const f32x4 w = *(const f32x4*)(C.in[I_RW] + (size_t)l * D * NE + (size_t)r * 4);
        *(f32x4*)(RWF + (size_t)ls * D * NE + (size_t)r * 4) = w * al;
    }
    if (C.vcu < 6) {
        const int l = C.vcu / 3, s = C.vcu % 3, e = C.tid & 31, kg = C.tid >> 5;
        LAS float* red = (LAS float*)C.lds;
        const float* sh = modp(C, l, s, 3); const float* rw = C.in[I_RW] + (size_t)l * D * NE;
        float a = 0.f, a2 = 0.f, a3 = 0.f, a4 = 0.f;
#pragma unroll 8
        for (int k = kg * 128; k < kg * 128 + 128; k += 4) { a += sh[k] * rw[(size_t)k * NE + e]; a2 += sh[k + 1] * rw[(size_t)(k + 1) * NE + e]; a3 += sh[k + 2] * rw[(size_t)(k + 2) * NE + e]; a4 += sh[k + 3] * rw[(size_t)(k + 3) * NE + e]; }
        a = (a + a2) + (a3 + a4);
        red[C.tid] = a;
        __syncthreads();
        if (C.tid < 32) { float v = C.in[I_RB][l * NE + e];
#pragma unroll
            for (int g = 0; g < 16; ++g) v += red[g * 32 + e];
            RC[(l * 3 + s) * NE + e] = v; }
        __syncthreads();
    }
}

constexpr int RT_LD = D + 4;
template <bool BASE16> __device__ __forceinline__ void ph_router(const Ctx& C, int layer, const void* Hlat_, const void* Hctx_, int nrows, bf16* Hout, bf16* FN, int lset) {
    const float* Hlat = (const float*)Hlat_; const float* Hctx = (const float*)Hctx_; const bf16* Hlat16 = (const bf16*)Hlat_;
    const bf16* DL = WSP(const bf16, WS_DELTA);
    const float* gain = C.in[I_N2G] + layer * D;
    int* list = WSP(int, WS_LIST) + (size_t)lset * NE * LCAP; float* plist = WSP(float, WS_PLIST) + (size_t)lset * NE * LCAP;
    unsigned* cnt = C.ctl + CW_CNT + lset * 64;
    LAS float* AR = (LAS float*)C.lds;
    LAS float* RED = AR + 16 * RT_LD;
    LAS float* RS = RED + 8 * 16 * 32;
    const int li = C.lane & 15, kq = C.lane >> 4;
    f32x4 xr[2][8]; u32x2 dr[2][8];
    auto load_task = [&](int tk) {
        const int r0 = tk * 16; const float* Hq = r0 < TL ? Hlat : Hctx - (size_t)TL * D;
#pragma unroll
        for (int rr = 0; rr < 2; ++rr) { const int row = r0 + 2 * C.wave + rr;
            if (BASE16) {
#pragma unroll
                for (int j = 0; j < 8; ++j) { const u32x2 w = *(const u32x2*)(Hlat16 + (size_t)row * D + 256 * j + 4 * C.lane); xr[rr][j] = (f32x4){bf_lo(w.x), bf_hi(w.x), bf_lo(w.y), bf_hi(w.y)}; }
            } else load_row_f32(Hq + (size_t)row * D, C.lane, xr[rr]);
#pragma unroll
            for (int j = 0; j < 8; ++j) dr[rr][j] = *(const u32x2*)(DL + (size_t)row * D + 256 * j + 4 * C.lane); }
    };
    if (C.vcu < nrows / 16) load_task(C.vcu);
    for (int task = C.vcu; task < nrows / 16; task += C.G) {
        const int row0 = task * 16, s = seg_of_row(row0);
#pragma unroll
        for (int rr = 0; rr < 2; ++rr) {
            const int rl = 2 * C.wave + rr, row = row0 + rl;
            float ss = 0.f;
#pragma unroll
            for (int j = 0; j < 8; ++j) {
                const int k = 256 * j + 4 * C.lane; const u32x2 dw = dr[rr][j]; f32x4 x = xr[rr][j];
                x.x += bf_lo(dw.x); x.y += bf_hi(dw.x); x.z += bf_lo(dw.y); x.w += bf_hi(dw.y);
                ss += (x.x * x.x + x.y * x.y) + (x.z * x.z + x.w * x.w);
                { u32x2 hw; hw.x = pk2(x.x, x.y); hw.y = pk2(x.z, x.w); *(u32x2*)(Hout + (size_t)row * D + k) = hw; }
                *(LAS f32x4*)(AR + rl * RT_LD + k) = x;
            }
            const float rstd = rsqrtf(wave_sum(ss) * (1.0f / D) + EPS);
            if (C.lane == 0) RS[rl] = rstd;
        }
        if (task + C.G < nrows / 16) load_task(task + C.G);
        __syncthreads();
        {
            const float* W = WSP(const float, WS_RWF) + (size_t)(layer * 3 + s) * D * NE + (size_t)(256 * C.wave + 4 * kq) * NE + li;
            LAS const float* ap = AR + li * RT_LD + 256 * C.wave + 4 * kq;
            f32x4 acc0 = {0.f, 0.f, 0.f, 0.f}, acc1 = acc0;
#pragma unroll 4
            for (int sp = 0; sp < 16; ++sp) {
                const f32x4 a = *(const LAS f32x4*)(ap + 16 * sp);
                float b0[4], b1[4];
#pragma unroll
                for (int j = 0; j < 4; ++j) { b0[j] = W[(size_t)(16 * sp + j) * NE]; b1[j] = W[(size_t)(16 * sp + j) * NE + 16]; }
#pragma unroll
                for (int j = 0; j < 4; ++j) {
                    acc0 = __builtin_amdgcn_mfma_f32_16x16x4f32(a[j], b0[j], acc0, 0, 0, 0);
                    acc1 = __builtin_amdgcn_mfma_f32_16x16x4f32(a[j], b1[j], acc1, 0, 0, 0);
                }
            }
#pragma unroll
            for (int r = 0; r < 4; ++r) { RED[(C.wave * 16 + 4 * kq + r) * 32 + li] = acc0[r]; RED[(C.wave * 16 + 4 * kq + r) * 32 + 16 + li] = acc1[r]; }
        }
        __syncthreads();
        if (C.wave == 0) {
            const float* RCv = WSP(const float, WS_RC) + (layer * 3 + s) * NE;
            const float c0 = RCv[li], c1 = RCv[16 + li];
            float k0[4], k1[4];
#pragma unroll
            for (int r = 0; r < 4; ++r) {
                float a0 = 0.f, a1 = 0.f;
#pragma unroll
                for (int w = 0; w < 8; ++w) { a0 += RED[(w * 16 + 4 * kq + r) * 32 + li]; a1 += RED[(w * 16 + 4 * kq + r) * 32 + 16 + li]; }
                const float rs = RS[4 * kq + r];
                k0[r] = __uint_as_float((__float_as_uint(a0 * rs + c0) & ~31u) | (unsigned)(31 - li));
                k1[r] = __uint_as_float((__float_as_uint(a1 * rs + c1) & ~31u) | (unsigned)(15 - li));
            }
            float tv[4][TOPK];
#pragma unroll
            for (int k = 0; k < TOPK; ++k)
#pragma unroll
                for (int r = 0; r < 4; ++r) {
                    float x = fmaxf(k0[r], k1[r]);
                    x = fmaxf(x, __uint_as_float((unsigned)__builtin_amdgcn_update_dpp(0, (int)__float_as_uint(x), 0xB1, 0xF, 0xF, true)));
                    x = fmaxf(x, __uint_as_float((unsigned)__builtin_amdgcn_update_dpp(0, (int)__float_as_uint(x), 0x4E, 0xF, 0xF, true)));
                    x = fmaxf(x, __uint_as_float((unsigned)__builtin_amdgcn_update_dpp(0, (int)__float_as_uint(x), 0x141, 0xF, 0xF, true)));
                    x = fmaxf(x, __uint_as_float((unsigned)__builtin_amdgcn_update_dpp(0, (int)__float_as_uint(x), 0x140, 0xF, 0xF, true)));
                    tv[r][k] = x;
                    if (__float_as_uint(k0[r]) == __float_as_uint(x)) k0[r] = -3.0e38f;
                    if (__float_as_uint(k1[r]) == __float_as_uint(x)) k1[r] = -3.0e38f;
                }
            const int r = li >> 2, k = li & 3; float sv = 0.f, mv = 0.f, den = 0.f;
#pragma unroll
            for (int rr = 0; rr < 4; ++rr) if (rr == r) {
                mv = tv[rr][0];
#pragma unroll
                for (int kk = 0; kk < TOPK; ++kk) { den += __expf(tv[rr][kk] - tv[rr][0]); if (kk == k) sv = tv[rr][kk]; }
            }
            const int se = 31 - (int)(__float_as_uint(sv) & 31u);
            const float p = __expf(sv - mv) / den;
            const int row = row0 + 4 * kq + r;
            const unsigned long long ltm = (1ull << C.lane) - 1ull; int myrank = 0, mycount = 0;
#pragma unroll 4
            for (int e = 0; e < NE; ++e) { const unsigned long long m = __ballot(se == e); if (se == e) myrank = __popcll(m & ltm); if (C.lane == e) mycount = __popcll(m); }
            unsigned base = 0u; if (C.lane < NE && mycount > 0) base = atomicAdd(cnt + C.lane, (unsigned)mycount);
            const unsigned pos = (unsigned)__shfl((int)base, se) + (unsigned)myrank;
            list[(size_t)se * LCAP + pos] = row * 4 + k;
            plist[(size_t)se * LCAP + pos] = p;
        }
        const float* scv = modp(C, layer, s, 4); const float* shv = modp(C, layer, s, 3);
#pragma unroll
        for (int rr = 0; rr < 2; ++rr) {
            const int rl = 2 * C.wave + rr, row = row0 + rl; const float rs = RS[rl];
            unsigned char* o = (unsigned char*)FN + (size_t)row * D;
#pragma unroll
            for (int j = 0; j < 8; ++j) {
                const int k = 256 * j + 4 * C.lane;
                const f32x4 x = *(const LAS f32x4*)(AR + rl * RT_LD + k), g = *(const f32x4*)(gain + k), s1 = *(const f32x4*)(scv + k), s0 = *(const f32x4*)(shv + k);
                const f32x4 y = x * rs * g * (1.0f + s1) + s0;
                *(unsigned*)(o + k) = pk4_fp8(y.x, y.y, y.z, y.w);
            }
        }
        __syncthreads();
    }
}

__device__ __forceinline__ void ph_combine(const Ctx& C, int layer, const bf16* Hin, const bf16* Yb, int nrows, bf16* Hout, bf16* XN, float* fout) {
    const unsigned char* Y = (const unsigned char*)Yb;
    const int gw = C.vcu * NWAVES + C.wave, NGW = C.G * NWAVES;
    LAS float* VG = (LAS float*)C.lds; LAS float* VA = VG + 3 * D; LAS float* VB = VA + 3 * D;
    for (int i = C.tid; i < 3 * (D / 4); i += NTHREADS) {
        const int sg = i / (D / 4), k = (i - sg * (D / 4)) * 4;
        *(LAS f32x4*)(VG + sg * D + k) = *(const f32x4*)(modp(C, layer, sg, 5) + k);
        if (XN) { *(LAS f32x4*)(VA + sg * D + k) = *(const f32x4*)(C.in[I_N1G] + (layer + 1) * D + k) * (1.0f + *(const f32x4*)(modp(C, layer + 1, sg, 1) + k)); *(LAS f32x4*)(VB + sg * D + k) = *(const f32x4*)(modp(C, layer + 1, sg, 0) + k); }
        else if (sg == 0) *(LAS f32x4*)(VA + k) = *(const f32x4*)(C.in[I_FG] + k);
    }
    __syncthreads();
    if (gw >= nrows) return;
    f32x4 x[4][2], xn[4][2]; u32x2 yw[4][4], yn[4][4];
    auto load_row = [&](int row, f32x4 (&xx)[4][2], u32x2 (&yy)[4][4]) {
#pragma unroll
        for (int j = 0; j < 4; ++j) {
            const int k = 512 * j + 8 * C.lane;
            { const u32x4 hw = __builtin_nontemporal_load((const u32x4*)(Hin + (size_t)row * D + k)); xx[j][0] = (f32x4){bf_lo(hw.x), bf_hi(hw.x), bf_lo(hw.y), bf_hi(hw.y)}; xx[j][1] = (f32x4){bf_lo(hw.z), bf_hi(hw.z), bf_lo(hw.w), bf_hi(hw.w)}; }
#pragma unroll
            for (int q = 0; q < 4; ++q) yy[j][q] = __builtin_nontemporal_load((const u32x2*)(Y + ((size_t)row * 4 + q) * D + k));
        }
    };
    load_row(gw, x, yw);
    for (int row = gw; row < nrows; row += NGW) {
        const int s = seg_of_row(row); LAS const float* g2 = VG + s * D;
        if (row + NGW < nrows) load_row(row + NGW, xn, yn);
        float ss = 0.f;
#pragma unroll
        for (int j = 0; j < 4; ++j) {
            const int k = 512 * j + 8 * C.lane; f32x4 s0 = {0.f, 0.f, 0.f, 0.f}, s1 = s0;
#pragma unroll
            for (int q = 0; q < 4; ++q) {
                const f32x2 a = __builtin_amdgcn_cvt_pk_f32_fp8((int)yw[j][q].x, false), b = __builtin_amdgcn_cvt_pk_f32_fp8((int)yw[j][q].x, true);
                const f32x2 c = __builtin_amdgcn_cvt_pk_f32_fp8((int)yw[j][q].y, false), d = __builtin_amdgcn_cvt_pk_f32_fp8((int)yw[j][q].y, true);
                s0.x += a.x; s0.y += a.y; s0.z += b.x; s0.w += b.y; s1.x += c.x; s1.y += c.y; s1.z += d.x; s1.w += d.y;
            }
            x[j][0] += *(LAS const f32x4*)(g2 + k) * s0; x[j][1] += *(LAS const f32x4*)(g2 + k + 4) * s1;
#pragma unroll
            for (int h = 0; h < 2; ++h) ss += (x[j][h].x * x[j][h].x + x[j][h].y * x[j][h].y) + (x[j][h].z * x[j][h].z + x[j][h].w * x[j][h].w);
        }
        const float rstd = rsqrtf(wave_sum(ss) * (1.0f / D) + EPS);
        if (XN) {
            LAS const float* va = VA + s * D; LAS const float* vb = VB + s * D;
#pragma unroll
            for (int j = 0; j < 4; ++j) {
                const int k = 512 * j + 8 * C.lane;
                { u32x4 hw; hw.x = pk2(x[j][0].x, x[j][0].y); hw.y = pk2(x[j][0].z, x[j][0].w); hw.z = pk2(x[j][1].x, x[j][1].y); hw.w = pk2(x[j][1].z, x[j][1].w); *(u32x4*)(Hout + (size_t)row * D + k) = hw; }
                f32x4 y[2];
#pragma unroll
                for (int h = 0; h < 2; ++h) y[h] = x[j][h] * rstd * *(LAS const f32x4*)(va + k + 4 * h) + *(LAS const f32x4*)(vb + k + 4 * h);
                if (F8_WXY) { u32x2 w; w.x = pk4_fp8(y[0].x, y[0].y, y[0].z, y[0].w); w.y = pk4_fp8(y[1].x, y[1].y, y[1].z, y[1].w); *(u32x2*)((unsigned char*)XN + (size_t)row * D + k) = w; }
                else { u32x4 w; w.x = pk2(y[0].x, y[0].y); w.y = pk2(y[0].z, y[0].w); w.z = pk2(y[1].x, y[1].y); w.w = pk2(y[1].z, y[1].w); *(u32x4*)(XN + (size_t)row * D + k) = w; }
            }
        } else {
#pragma unroll
            for (int j = 0; j < 4; ++j) {
                const int k = 512 * j + 8 * C.lane;
                *(f32x4*)(fout + (size_t)row * D + k) = x[j][0] * rstd * *(LAS const f32x4*)(VA + k); *(f32x4*)(fout + (size_t)row * D + k + 4) = x[j][1] * rstd * *(LAS const f32x4*)(VA + k + 4);
            }
        }
#pragma unroll
        for (int j = 0; j < 4; ++j) { x[j][0] = xn[j][0]; x[j][1] = xn[j][1];
#pragma unroll
            for (int q = 0; q < 4; ++q) yw[j][q] = yn[j][q]; }
    }
}

typedef float f32x16 __attribute__((ext_vector_type(16)));
constexpr int LRU_ALD = 272;
template <int DIR> __device__ __forceinline__ void lru_scan(f32x16 (&acc)[2][2], int hh, float& ch, float& cp) {
    float As[2][4], Us[2][4];
#pragma unroll
    for (int mt = 0; mt < 2; ++mt)
#pragma unroll
        for (int q = 0; q < 4; ++q) {
            float h = 0.f, p = 1.f;
#pragma unroll
            for (int ee = 0; ee < 4; ++ee) { const int e = DIR ? 3 - ee : ee; const float a = acc[mt][0][4 * q + e], u = acc[mt][1][4 * q + e]; h = a * h + u; p = p * a; acc[mt][1][4 * q + e] = h; acc[mt][0][4 * q + e] = p; }
            As[mt][q] = p; Us[mt][q] = h;
        }
    ch = 0.f; cp = 1.f;
#pragma unroll
    for (int ii = 0; ii < 8; ++ii) {
        const int i = DIR ? 7 - ii : ii, mt = i >> 2, q = i & 3;
        const float Ao = __shfl_xor(As[mt][q], 32), Uo = __shfl_xor(Us[mt][q], 32);
        const float A0 = hh ? Ao : As[mt][q], U0 = hh ? Uo : Us[mt][q], A1 = hh ? As[mt][q] : Ao, U1 = hh ? Us[mt][q] : Uo;
        const float Af = DIR ? A1 : A0, Uf = DIR ? U1 : U0, Al = DIR ? A0 : A1, Ul = DIR ? U0 : U1;
        const float ch1 = Af * ch + Uf, cp1 = Af * cp;
        const bool mine_first = DIR ? (hh == 1) : (hh == 0);
        const float myh = mine_first ? ch : ch1, myp = mine_first ? cp : cp1;
#pragma unroll
        for (int e = 0; e < 4; ++e) { const float pl = acc[mt][0][4 * q + e]; acc[mt][1][4 * q + e] += pl * myh; acc[mt][0][4 * q + e] = pl * myp; }
        ch = Al * ch1 + Ul; cp = Al * cp1;
    }
}
__device__ __forceinline__ void ph_lru(const Ctx& C) {
    const bf16* XB = WSP(const bf16, WS_XB); bf16* HL = WSP(bf16, WS_HL); bf16* PP = WSP(bf16, WS_PP); float* SA = WSP(float, WS_SA); float* SU = WSP(float, WS_SU);
    const float* Wc = C.in[I_LCW]; const float* Bc = C.in[I_LCB];
    LAS unsigned char* Bimg = C.lds;
    LAS unsigned char* Aimg = C.lds + 131072;
    LAS float* CW = (LAS float*)(C.lds + 131072 + 64 * LRU_ALD);
    const int d = C.wave >> 2, g = C.wave & 3, col = C.lane & 31, hh = C.lane >> 5;
    int hprev = -1; float ba = 0.f, bi = 0.f, sp8 = 0.f;
    u32x4 xr[4][2];
    auto load_rows = [&](int uu) {
        const int hq = uu & 15, cq = uu >> 4, r0 = cq * 64, t = C.tid >> 3, cg = C.tid & 7, row = r0 + t, chb = hq * HBLK + 16 * cg;
        int s0, s1; if (r0 < TL) { s0 = r0 & ~(SEQ - 1); s1 = s0 + SEQ; } else { s0 = TL + ((r0 - TL) & ~(CTXL - 1)); s1 = s0 + CTXL; }
#pragma unroll
        for (int q = 0; q < 4; ++q) { const int rr = row + q - 1; const int rc = (rr >= s0 && rr < s1) ? rr : row;
            xr[q][0] = *(const u32x4*)(XB + (size_t)rc * D + chb); xr[q][1] = *(const u32x4*)(XB + (size_t)rc * D + chb + 8); }
    };
    if (C.vcu < 136 * NHEAD) load_rows(C.vcu);
    for (int u = C.vcu; u < 136 * NHEAD; u += C.G) {
        const int h = u & 15, ci = u >> 4, row0 = ci * 64; const bool lat = ci < 128;
        if (h != hprev) {
            hprev = h;
            const float* Wa = C.in[I_WA] + (size_t)(d * NHEAD + h) * HBLK * HBLK + 32 * g + col + 8 * hh * HBLK; const float* Wi = C.in[I_WI] + (size_t)(d * NHEAD + h) * HBLK * HBLK + 32 * g + col + 8 * hh * HBLK;
#pragma unroll
            for (int ks = 0; ks < 8; ++ks) {
                float fa[8], fi[8];
                asm volatile("" : "+v"(Wa), "+v"(Wi));
#pragma unroll
                for (int j = 0; j < 8; ++j) { fa[j] = Wa[j * HBLK]; fi[j] = Wi[j * HBLK]; }
                Wa += 16 * HBLK; Wi += 16 * HBLK;
                u32x4 wa, wi; wa.x = pk2(fa[0], fa[1]); wa.y = pk2(fa[2], fa[3]); wa.z = pk2(fa[4], fa[5]); wa.w = pk2(fa[6], fa[7]);
                wi.x = pk2(fi[0], fi[1]); wi.y = pk2(fi[2], fi[3]); wi.z = pk2(fi[4], fi[5]); wi.w = pk2(fi[6], fi[7]);
                *(LAS u32x4*)(Bimg + ((C.wave * 2 + 0) * 8 + ks) * 1024 + C.lane * 16) = wa; *(LAS u32x4*)(Bimg + ((C.wave * 2 + 1) * 8 + ks) * 1024 + C.lane * 16) = wi;
            }
            const int cch = h * HBLK + 32 * g + col;
            ba = C.in[I_BA][d * D + cch]; bi = C.in[I_BI][d * D + cch]; sp8 = -8.0f * 1.4426950408889634f * log1pf(expf(-C.in[I_LAM][d * D + cch]));
            for (int i = C.tid; i < 5 * HBLK; i += NTHREADS) CW[i] = i < 4 * HBLK ? Wc[(i >> 7) * D + h * HBLK + (i & 127)] : Bc[h * HBLK + (i & 127)];
            __syncthreads();
        }
        {
            const int t = C.tid >> 3, cg = C.tid & 7, row = row0 + t, chb = h * HBLK + 16 * cg;
            int s0, s1; if (row0 < TL) { s0 = row0 & ~(SEQ - 1); s1 = s0 + SEQ; } else { s0 = TL + ((row0 - TL) & ~(CTXL - 1)); s1 = s0 + CTXL; }
            float o[16];
#pragma unroll
            for (int i = 0; i < 4; ++i) { const f32x4 b = *(const LAS f32x4*)(CW + 4 * HBLK + 16 * cg + 4 * i); o[4 * i] = b.x; o[4 * i + 1] = b.y; o[4 * i + 2] = b.z; o[4 * i + 3] = b.w; }
#pragma unroll
            for (int q = 0; q < 4; ++q) {
                const int rr = row + q - 1; const bool ok = rr >= s0 && rr < s1;
                const u32x4 x0 = xr[q][0], x1 = xr[q][1];
                const unsigned xw[8] = {x0.x, x0.y, x0.z, x0.w, x1.x, x1.y, x1.z, x1.w};
#pragma unroll
                for (int i = 0; i < 4; ++i) { f32x4 w = *(const LAS f32x4*)(CW + q * HBLK + 16 * cg + 4 * i); if (!ok) w = (f32x4){0.f, 0.f, 0.f, 0.f};
                    o[4 * i] += w.x * bf_lo(xw[2 * i]); o[4 * i + 1] += w.y * bf_hi(xw[2 * i]); o[4 * i + 2] += w.z * bf_lo(xw[2 * i + 1]); o[4 * i + 3] += w.w * bf_hi(xw[2 * i + 1]); }
            }
            u32x4 w0, w1; w0.x = pk2(o[0], o[1]); w0.y = pk2(o[2], o[3]); w0.z = pk2(o[4], o[5]); w0.w = pk2(o[6], o[7]);
            w1.x = pk2(o[8], o[9]); w1.y = pk2(o[10], o[11]); w1.z = pk2(o[12], o[13]); w1.w = pk2(o[14], o[15]);
            *(LAS u32x4*)(Aimg + t * LRU_ALD + cg * 32) = w0; *(LAS u32x4*)(Aimg + t * LRU_ALD + cg * 32 + 16) = w1;
        }
        __syncthreads();
        if (u + C.G < 136 * NHEAD) load_rows(u + C.G);
        f32x16 acc[2][2];
#pragma unroll
        for (int mt = 0; mt < 2; ++mt)
#pragma unroll
            for (int ri = 0; ri < 2; ++ri)
#pragma unroll
                for (int r = 0; r < 16; ++r) acc[mt][ri][r] = 0.f;
#pragma unroll
        for (int ks = 0; ks < 8; ++ks)
#pragma unroll
            for (int mt = 0; mt < 2; ++mt) {
                const bf16x8 af = *(const LAS bf16x8*)(Aimg + (32 * mt + col) * LRU_ALD + (16 * ks + 8 * hh) * 2);
                const bf16x8 b0 = *(const LAS bf16x8*)(Bimg + ((C.wave * 2 + 0) * 8 + ks) * 1024 + C.lane * 16), b1 = *(const LAS bf16x8*)(Bimg + ((C.wave * 2 + 1) * 8 + ks) * 1024 + C.lane * 16);
                acc[mt][0] = __builtin_amdgcn_mfma_f32_32x32x16_bf16(af, b0, acc[mt][0], 0, 0, 0);
                acc[mt][1] = __builtin_amdgcn_mfma_f32_32x32x16_bf16(af, b1, acc[mt][1], 0, 0, 0);
            }
#pragma unroll
        for (int mt = 0; mt < 2; ++mt)
#pragma unroll
            for (int r = 0; r < 16; ++r) {
                const int tk = 32 * mt + (r & 3) + 8 * (r >> 2) + 4 * hh;
                const float xv = bf_lo((unsigned)*(const LAS unsigned short*)(Aimg + tk * LRU_ALD + (32 * g + col) * 2));
                const float rg = __builtin_amdgcn_rcpf(1.0f + __builtin_amdgcn_exp2f(-1.4426950408889634f * (acc[mt][0][r] + ba))), ig = __builtin_amdgcn_rcpf(1.0f + __builtin_amdgcn_exp2f(-1.4426950408889634f * (acc[mt][1][r] + bi)));
                const float a = __builtin_amdgcn_exp2f(sp8 * rg);
                acc[mt][0][r] = a; acc[mt][1][r] = xv * ig * __builtin_amdgcn_sqrtf((1.0f - a) * (1.0f + a));
            }
        float ch, cp;
        if (d == 0) lru_scan<0>(acc, hh, ch, cp); else lru_scan<1>(acc, hh, ch, cp);
        const int cch = h * HBLK + 32 * g + col;
        if (lat) {
            const bool odd = (col & 1) != 0;
            size_t o = ((size_t)d * TL + row0 + 4 * hh + (odd ? 1 : 0)) * D + (cch & ~1);
#pragma unroll
            for (int mt = 0; mt < 2; ++mt)
#pragma unroll
                for (int q = 0; q < 4; ++q) {
#pragma unroll
                    for (int ep = 0; ep < 2; ++ep) {
                        asm volatile("" : "+v"(o));
                        const float h0 = acc[mt][1][4 * q + 2 * ep], h1 = acc[mt][1][4 * q + 2 * ep + 1], p0 = acc[mt][0][4 * q + 2 * ep], p1 = acc[mt][0][4 * q + 2 * ep + 1];
                        const float hx = __uint_as_float((unsigned)__builtin_amdgcn_update_dpp(0, (int)__float_as_uint(odd ? h0 : h1), 0xB1, 0xF, 0xF, true));
                        const float px = __uint_as_float((unsigned)__builtin_amdgcn_update_dpp(0, (int)__float_as_uint(odd ? p0 : p1), 0xB1, 0xF, 0xF, true));
                        *(unsigned*)(HL + o) = odd ? pk2(hx, h1) : pk2(h0, hx);
                        *(unsigned*)(PP + o) = odd ? pk2(px, p1) : pk2(p0, px);
                        o += 2 * D;
                    }
                    o += 4 * D;
                }
        }
        if (hh == 0) { SA[((size_t)ci * 2 + d) * D + cch] = cp; SU[((size_t)ci * 2 + d) * D + cch] = ch; }
        __syncthreads();
    }
}

__device__ __forceinline__ void ph_fixup(const Ctx& C) {
    const bf16* HL = WSP(const bf16, WS_HL); const bf16* PP = WSP(const bf16, WS_PP); const float* SA = WSP(const float, WS_SA); const float* SU = WSP(const float, WS_SU);
    const bf16* YL = WSP(const bf16, WS_YL); bf16* Z = WSP(bf16, WS_Z);
    for (int u = C.vcu; u < 128 * 2; u += C.G) {
        const int th = u & 1, ci = u >> 1, b = ci >> 6, j = ci & 63; const int ch = 4 * C.tid;
        f32x4 cf = {0.f, 0.f, 0.f, 0.f}, cb = cf;
#pragma unroll
        for (int q = 0; q < 4; ++q) { const size_t o = ((size_t)(128 + 4 * b + q) * 2 + 0) * D + ch; cf = *(const f32x4*)(SA + o) * cf + *(const f32x4*)(SU + o); }
        for (int j0 = 0; j0 < j; j0 += 8) {
            f32x4 ta[8], tu[8];
#pragma unroll
            for (int i = 0; i < 8; ++i) { const int jj = (j0 + i < j) ? j0 + i : j0; const size_t o = ((size_t)(64 * b + jj) * 2 + 0) * D + ch; ta[i] = *(const f32x4*)(SA + o); tu[i] = *(const f32x4*)(SU + o); }
#pragma unroll
            for (int i = 0; i < 8; ++i) if (j0 + i < j) cf = ta[i] * cf + tu[i];
        }
#pragma unroll
        for (int q = 3; q >= 0; --q) { const size_t o = ((size_t)(128 + 4 * b + q) * 2 + 1) * D + ch; cb = *(const f32x4*)(SA + o) * cb + *(const f32x4*)(SU + o); }
        for (int j0 = 63; j0 > j; j0 -= 8) {
            f32x4 ta[8], tu[8];
#pragma unroll
            for (int i = 0; i < 8; ++i) { const int jj = (j0 - i > j) ? j0 - i : j0; const size_t o = ((size_t)(64 * b + jj) * 2 + 1) * D + ch; ta[i] = *(const f32x4*)(SA + o); tu[i] = *(const f32x4*)(SU + o); }
#pragma unroll
            for (int i = 0; i < 8; ++i) if (j0 - i > j) cb = ta[i] * cb + tu[i];
        }
        const size_t o0 = (size_t)(ci * 64 + th * 32) * D + ch;
        u32x2 ra[4][5], rb[4][5];
        auto load4 = [&](int q0, u32x2 (&r)[4][5]) {
#pragma unroll
            for (int i = 0; i < 4; ++i) { const size_t o = o0 + (size_t)(q0 + i) * D;
                r[i][0] = __builtin_nontemporal_load((const u32x2*)(HL + o)); r[i][1] = __builtin_nontemporal_load((const u32x2*)(PP + o));
                r[i][2] = __builtin_nontemporal_load((const u32x2*)(HL + (size_t)TL * D + o)); r[i][3] = __builtin_nontemporal_load((const u32x2*)(PP + (size_t)TL * D + o));
                r[i][4] = __builtin_nontemporal_load((const u32x2*)(YL + o)); }
        };
        auto emit4 = [&](int q0, const u32x2 (&rr)[4][5]) {
#pragma unroll
            for (int i = 0; i < 4; ++i) { const size_t o = o0 + (size_t)(q0 + i) * D;
                const u32x2 hf = rr[i][0], pf = rr[i][1], hb = rr[i][2], pb = rr[i][3], yv = rr[i][4];
                float r[4];
                r[0] = (bf_lo(hf.x) + bf_lo(pf.x) * cf.x) + (bf_lo(hb.x) + bf_lo(pb.x) * cb.x);
                r[1] = (bf_hi(hf.x) + bf_hi(pf.x) * cf.y) + (bf_hi(hb.x) + bf_hi(pb.x) * cb.y);
                r[2] = (bf_lo(hf.y) + bf_lo(pf.y) * cf.z) + (bf_lo(hb.y) + bf_lo(pb.y) * cb.z);
                r[3] = (bf_hi(hf.y) + bf_hi(pf.y) * cf.w) + (bf_hi(hb.y) + bf_hi(pb.y) * cb.w);
                if (F8_WO) *(unsigned*)((unsigned char*)Z + o) = pk4_fp8(bf_lo(yv.x) * r[0], bf_hi(yv.x) * r[1], bf_lo(yv.y) * r[2], bf_hi(yv.y) * r[3]);
                else { u32x2 w; w.x = pk2(bf_lo(yv.x) * r[0], bf_hi(yv.x) * r[1]); w.y = pk2(bf_lo(yv.y) * r[2], bf_hi(yv.y) * r[3]); *(u32x2*)(Z + o) = w; } }
        };
        const int rot = 4 * (ci & 7);
        load4(rot, ra);
#pragma unroll 1
        for (int q = 0; q < 32; q += 8) {
            load4((q + 4 + rot) & 31, rb);
            emit4((q + rot) & 31, ra);
            if (q + 8 < 32) load4((q + 8 + rot) & 31, ra);
            emit4((q + 4 + rot) & 31, rb);
        }
    }
}
__device__ __forceinline__ void probe_thrash(const Ctx& C) {
    const u32x4* buf = (const u32x4*)(C.in[I_W1] + (size_t)NE * D * 2 * FF); const size_t n16 = (size_t)512 * MiB / 16; u32x4 acc = {0u, 0u, 0u, 0u};
    for (size_t i = (size_t)C.vcu * NTHREADS + C.tid; i < n16; i += (size_t)C.G * NTHREADS) { const u32x4 v = buf[i]; acc.x ^= v.x; acc.y ^= v.y; acc.z ^= v.z; acc.w ^= v.w; }
    if ((acc.x ^ acc.y ^ acc.z ^ acc.w) == 0x12345679u) C.ctl[CW_TMO + 2] = 1u;
}
constexpr int NPHASE = 20;
__global__ void __launch_bounds__(NTHREADS, 2) k_fwd(Args args) {
    extern __shared__ __attribute__((aligned(16))) unsigned char lds_raw[];
    Ctx C;
    C.lds = (LAS unsigned char*)lds_raw;
    C.tid = threadIdx.x; C.lane = C.tid & 63; C.wave = __builtin_amdgcn_readfirstlane(C.tid >> 6);
    C.G = gridDim.x; { const int bx = blockIdx.x; C.vcu = (C.G % 8 == 0) ? (bx % 8) * (C.G / 8) + bx / 8 : bx; }
    C.in = args.in; C.out = args.out; C.ws = args.ws; C.ctl = (unsigned*)(args.ws + WS_CTL);
    volatile LAS unsigned* MISC = (volatile LAS unsigned*)(C.lds + LDS_MISC);
    if (C.tid < 64) MISC[C.tid] = 0u;
    __syncthreads();
    const int lo = args.lo, hi = args.hi;
    XcdBarrier bar; bar.bar = C.ctl + CW_BAR; bar.x = 0; bar.st = MISC + 8;
    if (hi - lo > 1) bar = xcd_barrier_post(C.ctl + CW_BAR, MISC + 8);
#define IN(k) (lo <= (k) && (k) < hi)
#define SEAM(k) do { if (IN(k) && IN((k) + 1)) xcd_barrier(bar); } while (0)
    if (IN(0)) { for (int rep = 0; rep <= (PROBE_PHASE == 0 ? PROBE_REP : 0); ++rep) { if (rep) { xcd_barrier(bar); if (PROBE_COLD) { probe_thrash(C); xcd_barrier(bar); } if (PROBE_COLD == 2) continue; } ph_ada(C); if (CVT_ITEMS_BF > 0) ph_convert_bf16(C); ph_convert_fp8(C); } } SEAM(0);
    if (IN(1)) { for (int rep = 0; rep <= (PROBE_PHASE == 1 ? PROBE_REP : 0); ++rep) { if (rep) { xcd_barrier(bar); if (PROBE_COLD) { probe_thrash(C); xcd_barrier(bar); } if (PROBE_COLD == 2) continue; } ph_norm0(C); ph_fold_router(C); } } SEAM(1);
    if (IN(2)) { for (int rep = 0; rep <= (PROBE_PHASE == 2 ? PROBE_REP : 0); ++rep) { if (rep) { xcd_barrier(bar); if (PROBE_COLD) { probe_thrash(C); xcd_barrier(bar); } if (PROBE_COLD == 2) continue; } ph_pw1(C); } } SEAM(2);
    if (IN(3)) { for (int rep = 0; rep <= (PROBE_PHASE == 3 ? PROBE_REP : 0); ++rep) { if (rep) { xcd_barrier(bar); if (PROBE_COLD) { probe_thrash(C); xcd_barrier(bar); } if (PROBE_COLD == 2) continue; } { Ctx C2; if (side_ctx(C, NU_DWC, C2)) ph_dwconv(C2); cvt_side(C, NU_DWC, CQ_DWC, 0, cvt_share(NU_PW1, C.G, CQ_PW1)); } } } SEAM(3);
    if (IN(4)) { for (int rep = 0; rep <= (PROBE_PHASE == 4 ? PROBE_REP : 0); ++rep) { if (rep) { xcd_barrier(bar); if (PROBE_COLD) { probe_thrash(C); xcd_barrier(bar); } if (PROBE_COLD == 2) continue; } ph_ln_silu(C); } } SEAM(4);
    if (IN(5)) { for (int rep = 0; rep <= (PROBE_PHASE == 5 ? PROBE_REP : 0); ++rep) { if (rep) { xcd_barrier(bar); if (PROBE_COLD) { probe_thrash(C); xcd_barrier(bar); } if (PROBE_COLD == 2) continue; } ph_pw2(C); } } SEAM(5);
    if (IN(6)) { for (int rep = 0; rep <= (PROBE_PHASE == 6 ? PROBE_REP : 0); ++rep) { if (rep) { xcd_barrier(bar); if (PROBE_COLD) { probe_thrash(C); xcd_barrier(bar); } if (PROBE_COLD == 2) continue; } { Ctx C2; if (side_ctx(C, NU_RT0, C2)) ph_router<false>(C2, 0, C.in[I_X], C.in[I_CTX], TT, WSP(bf16, WS_H1), WSP(bf16, WS_FN0), rep ? 2 : 0); cvt_side(C, NU_RT0, CQ_RT0, 1, 0); } } } SEAM(6);
    if (IN(7)) { for (int rep = 0; rep <= (PROBE_PHASE == 7 ? PROBE_REP : 0); ++rep) { if (rep) { xcd_barrier(bar); if (PROBE_COLD) { probe_thrash(C); xcd_barrier(bar); } if (PROBE_COLD == 2) continue; } ph_moe1(C, 0, WSP(const bf16, WS_FN0), WSP(bf16, WS_ACT0)); } } SEAM(7);
    if (IN(8)) { for (int rep = 0; rep <= (PROBE_PHASE == 8 ? PROBE_REP : 0); ++rep) { if (rep) { xcd_barrier(bar); if (PROBE_COLD) { probe_thrash(C); xcd_barrier(bar); } if (PROBE_COLD == 2) continue; } ph_moe2(C, 0, WSP(const bf16, WS_ACT0), WSP(bf16, WS_Y0)); } } SEAM(8);
    if (IN(9)) { for (int rep = 0; rep <= (PROBE_PHASE == 9 ? PROBE_REP : 0); ++rep) { if (rep) { xcd_barrier(bar); if (PROBE_COLD) { probe_thrash(C); xcd_barrier(bar); } if (PROBE_COLD == 2) continue; } ph_combine(C, 0, WSP(const bf16, WS_H1), WSP(const bf16, WS_Y0), TT, WSP(bf16, WS_H2), WSP(bf16, WS_XN1), nullptr); } } SEAM(9);
    if (IN(10)) { for (int rep = 0; rep <= (PROBE_PHASE == 10 ? PROBE_REP : 0); ++rep) { if (rep) { xcd_barrier(bar); if (PROBE_COLD) { probe_thrash(C); xcd_barrier(bar); } if (PROBE_COLD == 2) continue; } ph_wxy(C); } } SEAM(10);
    if (IN(11)) { for (int rep = 0; rep <= (PROBE_PHASE == 11 ? PROBE_REP : 0); ++rep) { if (rep) { xcd_barrier(bar); if (PROBE_COLD) { probe_thrash(C); xcd_barrier(bar); } if (PROBE_COLD == 2) continue; } ph_lru(C); } } do { if (IN(11) && IN(14)) xcd_barrier(bar); } while (0);
    if (IN(14)) { for (int rep = 0; rep <= (PROBE_PHASE == 14 ? PROBE_REP : 0); ++rep) { if (rep) { xcd_barrier(bar); if (PROBE_COLD) { probe_thrash(C); xcd_barrier(bar); } if (PROBE_COLD == 2) continue; } ph_fixup(C); } } SEAM(14);
    if (IN(15)) { for (int rep = 0; rep <= (PROBE_PHASE == 15 ? PROBE_REP : 0); ++rep) { if (rep) { xcd_barrier(bar); if (PROBE_COLD) { probe_thrash(C); xcd_barrier(bar); } if (PROBE_COLD == 2) continue; } ph_wo(C); } } SEAM(15);
    if (IN(16)) { for (int rep = 0; rep <= (PROBE_PHASE == 16 ? PROBE_REP : 0); ++rep) { if (rep) { xcd_barrier(bar); if (PROBE_COLD) { probe_thrash(C); xcd_barrier(bar); } if (PROBE_COLD == 2) continue; } ph_router<true>(C, 1, WSP(const bf16, WS_H2), WSP(const bf16, WS_H2), TL, WSP(bf16, WS_H3), WSP(bf16, WS_FN1), rep ? 2 : 1); } } SEAM(16);
    if (IN(17)) { for (int rep = 0; rep <= (PROBE_PHASE == 17 ? PROBE_REP : 0); ++rep) { if (rep) { xcd_barrier(bar); if (PROBE_COLD) { probe_thrash(C); xcd_barrier(bar); } if (PROBE_COLD == 2) continue; } ph_moe1(C, 1, WSP(const bf16, WS_FN1), WSP(bf16, WS_ACT1)); } } SEAM(17);
    if (IN(18)) { for (int rep = 0; rep <= (PROBE_PHASE == 18 ? PROBE_REP : 0); ++rep) { if (rep) { xcd_barrier(bar); if (PROBE_COLD) { probe_thrash(C); xcd_barrier(bar); } if (PROBE_COLD == 2) continue; } ph_moe2(C, 1, WSP(const bf16, WS_ACT1), WSP(bf16, WS_Y1)); } } SEAM(18);
    if (IN(19)) { for (int rep = 0; rep <= (PROBE_PHASE == 19 ? PROBE_REP : 0); ++rep) { if (rep) { xcd_barrier(bar); if (PROBE_COLD) { probe_thrash(C); xcd_barrier(bar); } if (PROBE_COLD == 2) continue; } ph_combine(C, 1, WSP(const bf16, WS_H3), WSP(const bf16, WS_Y1), TL, nullptr, nullptr, C.out); } }
#undef IN
#undef SEAM
}

extern "C" void kernel_launch(void* const* d_in, const int* in_sizes, int n_in, void* d_out, int out_size, void* d_ws, size_t ws_size, hipStream_t stream) {
    static int grid = 0;
    if (grid == 0) {
        if (n_in != N_IN || out_size != TL * D || ws_size < WS_END) { fprintf(stderr, "kernel_launch: unexpected problem (n_in %d, out %d, ws %zu < %zu); nothing launched\n", n_in, out_size, ws_size, (size_t)WS_END); grid = -1; return; }
        int dev = 0, cus = 0, per_cu = 0;
        if (hipGetDevice(&dev) != hipSuccess || hipDeviceGetAttribute(&cus, hipDeviceAttributeMultiprocessorCount, dev) != hipSuccess) { grid = -1; return; }
        if (hipFuncSetAttribute((const void*)k_fwd, hipFuncAttributeMaxDynamicSharedMemorySize, LDS_BYTES) != hipSuccess) { fprintf(stderr, "kernel_launch: hipFuncSetAttribute failed\n"); grid = -1; return; }
        if (hipOccupancyMaxActiveBlocksPerMultiprocessor(&per_cu, (const void*)k_fwd, NTHREADS, LDS_BYTES) != hipSuccess || per_cu < 1) { fprintf(stderr, "kernel_launch: occupancy query says %d blocks per CU\n", per_cu); }
        (void)hipGetLastError();
        grid = cus;
    }
    if (grid < 0) return;
    (void)hipMemsetAsync((char*)d_ws + WS_CTL, 0, CTL_ZERO, stream);
    Args a{};
    for (int i = 0; i < N_IN; ++i) a.in[i] = (const float*)d_in[i];
    a.out = (float*)d_out; a.ws = (unsigned char*)d_ws;
#if MK_PER_PHASE
    for (int p = 0; p < NPHASE; ++p) { a.lo = p; a.hi = p + 1; hipLaunchKernelGGL(k_fwd, dim3(grid), dim3(NTHREADS), LDS_BYTES, stream, a); }
#else
    a.lo = 0; a.hi = NPHASE;
    hipLaunchKernelGGL(k_fwd, dim3(grid), dim3(NTHREADS), LDS_BYTES, stream, a);
#endif
    const hipError_t le = hipPeekAtLastError();
    if (le != hipSuccess) fprintf(stderr, "kernel_launch: launch failed: %s\n", hipGetErrorName(le));
}
```
